# Optimizing an MI355X kernel written in HIP

```python
import jax, jax.numpy as jnp
from jax import lax
import numpy as np

D_MODEL = 2048
BATCH = 32
SEQ = 256
DEPTH = 1
DEC_BATCH = 8
DEC_SEQ = 1024
PAST_LEN = 256

GRID_W = 64
H_MLA = 16
NOPE_DIM = 128
ROPE_DIM = 64
QK_HEAD = NOPE_DIM + ROPE_DIM
V_HEAD = 128
KV_RANK = 512
ROPE_THETA = 10000.0
AXIS_DIM = ROPE_DIM // 2
AXIS_PAIRS = AXIS_DIM // 2
Q_BLOCK = 128
MLA_WIDTH = H_MLA * V_HEAD
Q_DIM = H_MLA * QK_HEAD
HEAD_RWKV = 64
H_RWKV = D_MODEL // HEAD_RWKV
R_DIM = H_RWKV * HEAD_RWKV
W_LORA = 64
A_LORA = 64
G_LORA = 128
CONV_W = 3
N_DIR = 2
LNX_EPS = 64e-5
D_FF = 4 * D_MODEL
EPS = 1e-6
IN_SIZES = (Q_DIM, KV_RANK, ROPE_DIM, 3 * R_DIM, N_DIR * W_LORA, N_DIR * A_LORA, G_LORA, 2 * D_MODEL)
IN_DIM = Q_DIM + KV_RANK + ROPE_DIM + 3 * R_DIM + N_DIR * W_LORA + N_DIR * A_LORA + G_LORA + 2 * D_MODEL

kernel_name = 'hybrid_mla_rwkv7_dit_step'


def rms_norm(x, g):
    xf = x.astype(jnp.float32)
    y = xf * lax.rsqrt(jnp.mean(xf * xf, axis=-1, keepdims=True) + EPS)
    return (y * g.astype(jnp.float32)).astype(x.dtype)


def split_cols(z, sizes):
    out, off = [], 0
    for s in sizes:
        out.append(z[..., off:off + s])
        off += s
    return out


def rotate_pairs(x, ang):
    cos = jnp.cos(ang).astype(x.dtype)[None, :, None, :]
    sin = jnp.sin(ang).astype(x.dtype)[None, :, None, :]
    x1, x2 = x[..., :AXIS_PAIRS], x[..., AXIS_PAIRS:]
    return jnp.concatenate([x1 * cos - x2 * sin, x2 * cos + x1 * sin], axis=-1)


def axial_rope(x):
    T = x.shape[1]
    rows = T // GRID_W
    row = jnp.repeat(jnp.arange(rows, dtype=jnp.float32), GRID_W)
    col = jnp.tile(jnp.arange(GRID_W, dtype=jnp.float32), rows)
    inv_freq = jnp.power(ROPE_THETA, -jnp.arange(AXIS_PAIRS, dtype=jnp.float32) / AXIS_PAIRS)
    x_nope = x[..., :NOPE_DIM]
    x_row = x[..., NOPE_DIM:NOPE_DIM + AXIS_DIM]
    x_col = x[..., NOPE_DIM + AXIS_DIM:]
    return jnp.concatenate([x_nope, rotate_pairs(x_row, row[:, None] * inv_freq),
                            rotate_pairs(x_col, col[:, None] * inv_freq)], axis=-1)


def mla_keys_values(ckv, kr, p):
    B, L, _ = ckv.shape
    kv = (rms_norm(ckv, p['kv_norm']) @ p['w_kv_up']).reshape(B, L, H_MLA, NOPE_DIM + V_HEAD)
    k_rope = jnp.broadcast_to(kr[:, :, None, :], (B, L, H_MLA, ROPE_DIM))
    k = rms_norm(jnp.concatenate([kv[..., :NOPE_DIM], k_rope], axis=-1), p['k_norm'])
    return k, kv[..., NOPE_DIM:]


def block_attention(q, k, v):
    B, T, H, _ = q.shape
    nb = T // Q_BLOCK
    qb = jnp.moveaxis(q.reshape(B, nb, Q_BLOCK, H, QK_HEAD), 1, 0)
    scale = QK_HEAD ** -0.5

    def one_block(q_blk):
        s = jnp.einsum('bqhd,bkhd->bhqk', q_blk, k).astype(jnp.float32) * scale
        pr = jax.nn.softmax(s, axis=-1).astype(v.dtype)
        return jnp.einsum('bhqk,bkhd->bqhd', pr, v)

    o = lax.map(one_block, qb)
    return jnp.moveaxis(o, 0, 1).reshape(B, T, H * V_HEAD)


def centred_conv(x, w):
    xp = jnp.pad(x, ((0, 0), (1, 1), (0, 0)))
    return xp[:, :-2] * w[0] + xp[:, 1:-1] * w[1] + xp[:, 2:] * w[2]


def l2_normalize(x):
    xf = x.astype(jnp.float32)
    return (xf * lax.rsqrt(jnp.sum(xf * xf, axis=-1, keepdims=True) + 1e-12)).astype(x.dtype)


def rwkv7_scan(r, decay, k, v, kk, a, s0, reverse):
    seq = tuple(jnp.swapaxes(t.astype(jnp.float32), 0, 1) for t in (r, decay, k, v, kk, a))

    def step(S, inp):
        r_t, w_t, k_t, v_t, kk_t, a_t = inp
        s_kk = jnp.einsum('bhvk,bhk->bhv', S, kk_t)
        S = (S * w_t[:, :, None, :]
             - jnp.einsum('bhv,bhk->bhvk', s_kk, kk_t * a_t)
             + jnp.einsum('bhv,bhk->bhvk', v_t, k_t))
        return S, jnp.einsum('bhvk,bhk->bhv', S, r_t)

    s_fin, ys = lax.scan(step, s0.astype(jnp.float32), seq, reverse=reverse)
    return jnp.swapaxes(ys, 0, 1), s_fin


def head_group_norm(y, w, b):
    mu = jnp.mean(y, axis=-1, keepdims=True)
    var = jnp.mean(jnp.square(y - mu), axis=-1, keepdims=True)
    yn = ((y - mu) * lax.rsqrt(var + LNX_EPS)).reshape(y.shape[:2] + (R_DIM,))
    return yn * w.astype(jnp.float32) + b.astype(jnp.float32)


def rwkv7_branch(z_rkv, z_wd, z_ad, z_gd, p, s0):
    B, T, _ = z_rkv.shape
    rkv = centred_conv(z_rkv, p['conv_rkv'])
    r, k, v = [t.reshape(B, T, H_RWKV, HEAD_RWKV) for t in jnp.split(rkv, 3, axis=-1)]
    kk = l2_normalize(k * p['k_k'].reshape(H_RWKV, HEAD_RWKV))
    g = jax.nn.sigmoid(z_gd) @ p['g_up']
    wd = z_wd.reshape(B, T, N_DIR, W_LORA)
    ad = z_ad.reshape(B, T, N_DIR, A_LORA)
    k_a = p['k_a'].reshape(H_RWKV, HEAD_RWKV)
    ys, bonuses, finals = [], [], []
    for d in range(N_DIR):
        w_log = -jax.nn.softplus(-(p['w0'][d] + jnp.tanh(wd[:, :, d]) @ p['w_up'][d])) - 0.5
        decay = jnp.exp(-jnp.exp(w_log.astype(jnp.float32))).reshape(B, T, H_RWKV, HEAD_RWKV)
        a = jax.nn.sigmoid(p['a0'][d] + ad[:, :, d] @ p['a_up'][d]).reshape(B, T, H_RWKV, HEAD_RWKV)
        k_d = k * (1.0 + (a - 1.0) * k_a)
        y, s_fin = rwkv7_scan(r, decay, k_d, v, kk, a, s0[:, d], reverse=(d == 1))
        ys.append(y)
        bonuses.append(jnp.sum(r * k_d * p['r_k'], axis=-1, keepdims=True) * v)
        finals.append(s_fin)
    o = head_group_norm(ys[0] + ys[1], p['lnx_w'], p['lnx_b']).astype(z_rkv.dtype)
    o = o + (bonuses[0] + bonuses[1]).reshape(B, T, R_DIM)
    return o * g, jnp.stack(finals, axis=1)


def trunk_layer(x, cond, p, cache):
    B, T, _ = x.shape
    mod = (jax.nn.silu(cond) @ p['w_ada'] + p['b_ada']).reshape(-1, 1, 6 * D_MODEL)
    shift1, scale1, gate1, shift2, scale2, gate2 = jnp.split(mod, 6, axis=-1)
    h = rms_norm(x, p['norm1']) * (1.0 + scale1) + shift1
    z_q, z_ckv, z_kr, z_rkv, z_wd, z_ad, z_gd, z_gate = split_cols(h @ p['w_in'], IN_SIZES)
    q = rms_norm(z_q.reshape(B, T, H_MLA, QK_HEAD), p['q_norm'])
    k, v = mla_keys_values(z_ckv, z_kr, p)
    if cache is None:
        s0 = jnp.zeros((B, N_DIR, H_RWKV, HEAD_RWKV, HEAD_RWKV), jnp.float32)
    else:
        ckv_ctx, kr_ctx, s0 = cache
        q = axial_rope(q)
        k = axial_rope(k)
        k_ctx, v_ctx = mla_keys_values(ckv_ctx, kr_ctx, p)
        k = jnp.concatenate([k, k_ctx], axis=1)
        v = jnp.concatenate([v, v_ctx], axis=1)
    o_mla = block_attention(q, k, v)
    o_rwkv, s_final = rwkv7_branch(z_rkv, z_wd, z_ad, z_gd, p, s0)
    gates = jax.nn.sigmoid(z_gate)
    merged = (gates[..., :D_MODEL] * (o_mla @ p['w_br_mla'])
              + gates[..., D_MODEL:] * (o_rwkv @ p['w_br_rwkv']))
    x = x + gate1 * (merged @ p['w_out'])
    h2 = rms_norm(x, p['norm2']) * (1.0 + scale2) + shift2
    x = x + gate2 * (jnp.square(jax.nn.relu(h2 @ p['w_ff_in'])) @ p['w_ff_out'])
    return x, (z_ckv, z_kr, s_final)


def setup_inputs(seed: int = 0) -> dict:
    key = jax.random.key(seed)
    ks = iter(jax.random.split(key, 40))

    def nrm(shape, scale):
        return scale * jax.random.normal(next(ks), shape, jnp.float32)

    L = DEPTH
    R = R_DIM
    conv = nrm((L, CONV_W, 3 * R), 0.2).at[:, CONV_W // 2].add(1.0)
    return {
        'x_prompt': nrm((BATCH, SEQ, D_MODEL), 1.0),
        'x_sample': nrm((DEC_BATCH, DEC_SEQ, D_MODEL), 1.0),
        'cache_mla_ckv': nrm((DEC_BATCH, L, PAST_LEN, KV_RANK), 1.0),
        'cache_mla_kr': nrm((DEC_BATCH, L, PAST_LEN, ROPE_DIM), 1.0),
        'state_rwkv': nrm((DEC_BATCH, L, N_DIR, H_RWKV, HEAD_RWKV, HEAD_RWKV), 1.0),
        'c': nrm((DEC_BATCH, D_MODEL), 1.0),
        'c_ctx': nrm((D_MODEL,), 1.0),
        'norm1': 1.0 + nrm((L, D_MODEL), 0.05),
        'w_ada': nrm((L, D_MODEL, 6 * D_MODEL), 0.01),
        'b_ada': nrm((L, 6 * D_MODEL), 0.1),
        'w_in': nrm((L, D_MODEL, IN_DIM), D_MODEL ** -0.5),
        'q_norm': 1.0 + nrm((L, QK_HEAD), 0.05),
        'kv_norm': 1.0 + nrm((L, KV_RANK), 0.05),
        'w_kv_up': nrm((L, KV_RANK, H_MLA * (NOPE_DIM + V_HEAD)), KV_RANK ** -0.5),
        'k_norm': 1.0 + nrm((L, QK_HEAD), 0.05),
        'conv_rkv': conv,
        'k_k': 0.85 + nrm((L, R), 0.05),
        'k_a': 1.0 + nrm((L, R), 0.05),
        'r_k': nrm((L, H_RWKV, HEAD_RWKV), 0.1),
        'w0': -1.5 + nrm((L, N_DIR, R), 0.5),
        'w_up': nrm((L, N_DIR, W_LORA, R), 0.5 * W_LORA ** -0.5),
        'a0': nrm((L, N_DIR, R), 0.1),
        'a_up': nrm((L, N_DIR, A_LORA, R), A_LORA ** -0.5),
        'g_up': nrm((L, G_LORA, R), G_LORA ** -0.5),
        'lnx_w': 1.0 + nrm((L, R), 0.05),
        'lnx_b': nrm((L, R), 0.01),
        'w_br_mla': nrm((L, MLA_WIDTH, D_MODEL), MLA_WIDTH ** -0.5),
        'w_br_rwkv': nrm((L, R, D_MODEL), R ** -0.5),
        'w_out': nrm((L, D_MODEL, D_MODEL), D_MODEL ** -0.5),
        'norm2': 1.0 + nrm((L, D_MODEL), 0.05),
        'w_ff_in': nrm((L, D_MODEL, D_FF), D_MODEL ** -0.5),
        'w_ff_out': nrm((L, D_FF, D_MODEL), D_FF ** -0.5),
    }


def reference(x_prompt, x_sample, cache_mla_ckv, cache_mla_kr, state_rwkv, c, c_ctx,
              norm1, w_ada, b_ada, w_in, q_norm, kv_norm, w_kv_up, k_norm, conv_rkv,
              k_k, k_a, r_k, w0, w_up, a0, a_up, g_up, lnx_w, lnx_b,
              w_br_mla, w_br_rwkv, w_out, norm2, w_ff_in, w_ff_out):
    x_p = x_prompt
    x_s = x_sample
    ckv_list, kr_list, st_list = [], [], []
    for l in range(DEPTH):
        p = {
            'norm1': norm1[l], 'w_ada': w_ada[l], 'b_ada': b_ada[l], 'w_in': w_in[l],
            'q_norm': q_norm[l], 'kv_norm': kv_norm[l], 'w_kv_up': w_kv_up[l], 'k_norm': k_norm[l],
            'conv_rkv': conv_rkv[l], 'k_k': k_k[l], 'k_a': k_a[l], 'r_k': r_k[l],
            'w0': w0[l], 'w_up': w_up[l], 'a0': a0[l], 'a_up': a_up[l], 'g_up': g_up[l],
            'lnx_w': lnx_w[l], 'lnx_b': lnx_b[l], 'w_br_mla': w_br_mla[l], 'w_br_rwkv': w_br_rwkv[l],
            'w_out': w_out[l], 'norm2': norm2[l], 'w_ff_in': w_ff_in[l], 'w_ff_out': w_ff_out[l],
        }
        x_p, (ckv_l, kr_l, st_l) = trunk_layer(x_p, c_ctx, p, None)
        ckv_list.append(ckv_l)
        kr_list.append(kr_l)
        st_list.append(st_l)
        x_s, _ = trunk_layer(x_s, c, p, (cache_mla_ckv[:, l], cache_mla_kr[:, l], state_rwkv[:, l]))
    new_cache_mla_ckv = jnp.stack(ckv_list, axis=1)
    new_cache_mla_kr = jnp.stack(kr_list, axis=1)
    new_state_rwkv = jnp.stack(st_list, axis=1)
    return (x_p, x_s, new_cache_mla_ckv, new_cache_mla_kr, new_state_rwkv)
```

```cpp
#include <hip/hip_runtime.h>
#include <hip/hip_cooperative_groups.h>
#include <cstdio>
namespace cg = cooperative_groups;

typedef unsigned short bf16_t;
typedef short bf16x8 __attribute__((ext_vector_type(8)));
typedef short s16x4 __attribute__((ext_vector_type(4)));
typedef float f32x4 __attribute__((ext_vector_type(4)));
typedef float f32x16 __attribute__((ext_vector_type(16)));
typedef unsigned u32x4 __attribute__((ext_vector_type(4)));
typedef unsigned u32x2 __attribute__((ext_vector_type(2)));

constexpr int NT = 16384, NPR = 8192;
constexpr size_t MiB = 1ull << 20;
constexpr size_t OFF_ZRKV = 0, OFF_H = 192 * MiB, OFF_WTIN = 256 * MiB, OFF_WTKV = 312 * MiB, OFF_ZCKV = 316 * MiB, OFF_MISC = 348 * MiB,
                 OFF_CKVN = 380 * MiB, OFF_BON = 494 * MiB, OFF_MOD = 402 * MiB, OFF_ROPE = 403 * MiB, OFF_XBAR = 404 * MiB, OFF_ORWKV = 406 * MiB,
                 OFF_WTBRM = 470 * MiB, OFF_WTBRR = 478 * MiB, OFF_WTOUT = 486 * MiB, WS_NEED = 510 * MiB;
constexpr size_t OFF_ZQ = 0, OFF_V = 96 * MiB, OFF_K = 192 * MiB, OFF_OMLA = 316 * MiB, OFF_MERGED = 0, OFF_H2 = 256 * MiB,
                 OFF_WTFFIN = 320 * MiB, OFF_WTFFOUT = 352 * MiB, OFF_FF = 0, OFF_X1 = 406 * MiB;
constexpr size_t OUT_CKV = 33554432, OUT_KR = 37748736, OUT_ST = 38273024;
constexpr int SHM_BYTES = 131072;

struct Params { const float* in[32]; float* out; char* ws; };
enum { I_XP = 0, I_XS, I_CCKV, I_CKR, I_STATE, I_C, I_CCTX, I_NORM1, I_WADA, I_BADA, I_WIN, I_QNORM, I_KVNORM, I_WKVUP, I_KNORM, I_CONV,
       I_KK, I_KA, I_RK, I_W0, I_WUP, I_A0, I_AUP, I_GUP, I_LNXW, I_LNXB, I_WBRM, I_WBRR, I_WOUT, I_NORM2, I_WFFIN, I_WFFOUT };

extern __shared__ __attribute__((aligned(16))) char smem[];

typedef float f32x2_ __attribute__((ext_vector_type(2)));
typedef __bf16 bf16x2_ __attribute__((ext_vector_type(2)));
__device__ __forceinline__ unsigned cvtpk(float lo, float hi) { f32x2_ v = {lo, hi}; bf16x2_ b = __builtin_convertvector(v, bf16x2_); return *reinterpret_cast<unsigned*>(&b); }
__device__ __forceinline__ float bf2f(bf16_t b) { return __uint_as_float(((unsigned)b) << 16); }
__device__ __forceinline__ bf16_t f2bf(float x) { return (bf16_t)(cvtpk(x, 0.f) & 0xffffu); }
#define DPPF(x, ctrl) __int_as_float(__builtin_amdgcn_update_dpp(0, __float_as_int(x), (ctrl), 0xf, 0xf, false))
__device__ __forceinline__ float rowsum16(float v) { v += DPPF(v, 0xB1); v += DPPF(v, 0x4E); v += DPPF(v, 0x141); v += DPPF(v, 0x140); return v; }
__device__ __forceinline__ float wsum(float v) {
  v = rowsum16(v);
  const int iv = __float_as_int(v);
  return __int_as_float(__builtin_amdgcn_readlane(iv, 0)) + __int_as_float(__builtin_amdgcn_readlane(iv, 16)) + __int_as_float(__builtin_amdgcn_readlane(iv, 32)) + __int_as_float(__builtin_amdgcn_readlane(iv, 48));
}
__device__ __forceinline__ float fexp(float x) { return __builtin_amdgcn_exp2f(x * 1.4426950408889634f); }
__device__ __forceinline__ float sigmoidf_(float x) { return __builtin_amdgcn_rcpf(1.f + fexp(-x)); }
__device__ __forceinline__ int otid() { int t = threadIdx.x; asm volatile("" : "+v"(t)); return t; }
__device__ __forceinline__ int cond_of(int row) { return row < NPR ? 0 : 1 + ((row - NPR) >> 10); }
__device__ __forceinline__ int xcd_bid() { const int G = gridDim.x, b = blockIdx.x; return (G % 8 == 0) ? (b % 8) * (G / 8) + b / 8 : b; }

constexpr int BM = 256, BK = 64, HALF = 128, HT = HALF * BK;
__device__ __forceinline__ int lds_byte(int r, int c) {
  int st = (r >> 4) * 2 + (c >> 5), rr = r & 15, cc = c & 31, ob = rr * 64 + cc * 2;
  return st * 1024 + (ob ^ (((ob >> 9) & 1) << 5));
}
__device__ __forceinline__ void stage_rc(int b, int& R, int& C) {
  int st = b / 1024, sb = b % 1024, swz = sb ^ (((sb >> 9) & 1) << 5);
  R = (st >> 1) * 16 + swz / 64; C = (st & 1) * 32 + (swz % 64) / 2;
}

#define LAS __attribute__((address_space(3)))
constexpr int HTB = HALF * BK * 2;
struct Unit { int pm, pn; };
struct Order {
  int total, nig, G, b0;
  __device__ __forceinline__ void init(int nM, int nN) { total = nM * nN; nig = 8 * nN; G = gridDim.x; b0 = xcd_bid(); }
  __device__ __forceinline__ bool next(int i, Unit& u) const { const int id = i * G + b0; if (id >= total) return false;
    const int gid = id / nig, w = id % nig; u.pm = gid * 8 + (w & 7); u.pn = w >> 3; return true; }
};
template <class Epi>
__device__ __forceinline__ void gemm_phase(const bf16_t* __restrict__ gA, const bf16_t* __restrict__ gBt, const int K, const int nM, const int nN, Epi& E,
                                           const bf16_t* __restrict__ gA2 = nullptr, const bf16_t* __restrict__ gBt2 = nullptr) {
  constexpr bool DUAL = Epi::DUAL;
  LAS unsigned char* lds = (LAS unsigned char*)smem;
  const int tid = otid(), wid = __builtin_amdgcn_readfirstlane(tid >> 6), lane = tid & 63, wr = wid >> 2, wc = wid & 3, fr = lane & 15, fq = lane >> 4;
  const int nt = K / BK;
  Order S; S.init(nM, nN);
  unsigned voffA[2];
#pragma unroll
  for (int i = 0; i < 2; ++i) { int R, C; stage_rc(tid * 16 + i * 8192, R, C); voffA[i] = (unsigned)(R * K + C) * 2u; }
  const size_t kstep = (size_t)(BK * 2), hstep = (size_t)HALF * K * 2, tstep = 2 * hstep;
  const unsigned ldsw = (unsigned)wid * 1024u;
  const int aoff = lds_byte(wr * 64 + fr, fq * 8), boff = lds_byte(wc * 32 + fr, fq * 8);
#define PG8_SA(b, h) (((b) * 2 + (h)) * HTB)
#define PG8_SB(b, h) ((4 + (b) * 2 + (h)) * HTB)
#define PG8_STAGE(bufoff, gbase) do { _Pragma("unroll") for (int _i = 0; _i < 2; ++_i) \
    __builtin_amdgcn_global_load_lds((const unsigned*)((const char*)(gbase) + voffA[_i]), (LAS unsigned*)(lds + (bufoff) + ldsw + _i * 8192), 16, 0, 0); } while (0)
#define PG8_LDA(dst, b, h) do { _Pragma("unroll") for (int m = 0; m < 4; ++m) _Pragma("unroll") for (int k = 0; k < 2; ++k) dst[m][k] = *(const LAS bf16x8*)(lds + PG8_SA(b, h) + aoff + m * 2048 + k * 1024); } while (0)
#define PG8_LDB(dst, b, h) do { _Pragma("unroll") for (int n = 0; n < 2; ++n) _Pragma("unroll") for (int k = 0; k < 2; ++k) dst[n][k] = *(const LAS bf16x8*)(lds + PG8_SB(b, h) + boff + n * 2048 + k * 1024); } while (0)
#define PG8_MMA(ai, bj, At, Bt) do { __builtin_amdgcn_s_setprio(1); _Pragma("unroll") for (int m = 0; m < 4; ++m) _Pragma("unroll") for (int n = 0; n < 2; ++n) _Pragma("unroll") for (int k = 0; k < 2; ++k) \
    acc[ai][bj][m][n] = __builtin_amdgcn_mfma_f32_16x16x32_bf16(Bt[n][k], At[m][k], acc[ai][bj][m][n], 0, 0, 0); __builtin_amdgcn_s_setprio(0); } while (0)
#define PG8_WAIT_V(n) asm volatile("s_waitcnt vmcnt(" #n ")" ::: "memory")
#define PG8_WAIT_L(n) asm volatile("s_waitcnt lgkmcnt(" #n ")" ::: "memory")
#define PG8_BAR __builtin_amdgcn_s_barrier()
#define PG8_SCHED __builtin_amdgcn_sched_barrier(0)
  Unit cur, nxt; int ui = 0, csub = 0, nsub = 0;
  __syncthreads();
  if (!S.next(0, cur)) return;
  f32x4 acc[2][2][4][2];
#pragma unroll
  for (int a = 0; a < 2; ++a)
#pragma unroll
    for (int b = 0; b < 2; ++b)
#pragma unroll
      for (int m = 0; m < 4; ++m)
#pragma unroll
        for (int n = 0; n < 2; ++n) acc[a][b][m][n] = (f32x4){0.f, 0.f, 0.f, 0.f};
  bf16x8 At[4][2], B0[2][2], B1[2][2];
  const char* cA = (const char*)gA + (size_t)cur.pm * tstep; const char* cB = (const char*)gBt + (size_t)cur.pn * tstep;
  PG8_STAGE(PG8_SB(0, 0), cB); PG8_STAGE(PG8_SA(0, 0), cA); PG8_STAGE(PG8_SB(0, 1), cB + hstep); PG8_STAGE(PG8_SA(0, 1), cA + hstep);
  if (wr == 1) PG8_BAR;
  PG8_WAIT_V(4); PG8_BAR;
  PG8_STAGE(PG8_SB(1, 0), cB + kstep); PG8_STAGE(PG8_SA(1, 0), cA + kstep); PG8_STAGE(PG8_SB(1, 1), cB + hstep + kstep);
  PG8_WAIT_V(6); PG8_BAR;
  for (;;) {
    bool has_next;
    if constexpr (DUAL) { nsub = (ui + 1) & 1; has_next = S.next((ui + 1) >> 1, nxt); } else has_next = S.next(ui + 1, nxt);
    const char* nAb = (const char*)((DUAL && nsub) ? gA2 : gA); const char* nBb = (const char*)((DUAL && nsub) ? gBt2 : gBt);
    const char* nA = has_next ? nAb + (size_t)nxt.pm * tstep : cA; const char* nB = has_next ? nBb + (size_t)nxt.pn * tstep : cB;
    for (int t = 0; t < nt; t += 2) {
      const bool last = (t == nt - 2);
      const char* a1 = cA + (size_t)(t + 1) * kstep;
      const char* a2 = last ? nA : cA + (size_t)(t + 2) * kstep; const char* b2 = last ? nB : cB + (size_t)(t + 2) * kstep;
      const char* a3 = a2 + kstep; const char* b3 = b2 + kstep;
      PG8_LDB(B0, 0, 0); PG8_SCHED; PG8_LDA(At, 0, 0); PG8_STAGE(PG8_SA(1, 1), a1 + hstep);
      PG8_WAIT_L(8); PG8_BAR; PG8_WAIT_L(0); PG8_MMA(0, 0, At, B0); PG8_BAR; PG8_SCHED;
      PG8_LDB(B1, 0, 1); PG8_STAGE(PG8_SB(0, 0), b2);
      PG8_BAR; PG8_WAIT_L(0); PG8_MMA(0, 1, At, B1); PG8_BAR;
      PG8_LDA(At, 0, 1); PG8_STAGE(PG8_SA(0, 0), a2);
      PG8_BAR; PG8_WAIT_L(0); PG8_MMA(1, 0, At, B0); PG8_BAR; PG8_SCHED;
      PG8_STAGE(PG8_SB(0, 1), b2 + hstep);
      PG8_WAIT_V(6); PG8_BAR; PG8_MMA(1, 1, At, B1); PG8_BAR;
      PG8_LDB(B0, 1, 0); PG8_SCHED; PG8_LDA(At, 1, 0); PG8_STAGE(PG8_SA(0, 1), a2 + hstep);
      PG8_WAIT_L(8); PG8_BAR; PG8_WAIT_L(0); PG8_MMA(0, 0, At, B0); PG8_BAR; PG8_SCHED;
      PG8_LDB(B1, 1, 1); PG8_STAGE(PG8_SB(1, 0), b3);
      PG8_BAR; PG8_WAIT_L(0); PG8_MMA(0, 1, At, B1); PG8_BAR;
      PG8_LDA(At, 1, 1); PG8_STAGE(PG8_SA(1, 0), a3);
      PG8_BAR; PG8_WAIT_L(0); PG8_MMA(1, 0, At, B0); PG8_BAR; PG8_SCHED;
      PG8_STAGE(PG8_SB(1, 1), b3 + hstep);
      PG8_WAIT_V(6); PG8_BAR; PG8_MMA(1, 1, At, B1); PG8_BAR;
    }
    const bool midpoint = DUAL && csub == 0;
    if constexpr (DUAL) { if (midpoint) { const int row0 = cur.pm * BM + wr * 64 + fr, col0 = cur.pn * BM + wc * 32 + fq * 8;
#pragma unroll
      for (int ai = 0; ai < 2; ++ai) {
        typename Epi::Aux aux[8];
#pragma unroll
        for (int m = 0; m < 4; ++m)
#pragma unroll
          for (int bj = 0; bj < 2; ++bj) E.loadmid(row0 + ai * HALF + m * 16, col0 + bj * HALF, aux[m * 2 + bj]);
        __builtin_amdgcn_sched_barrier(0);
#pragma unroll
        for (int m = 0; m < 4; ++m)
#pragma unroll
          for (int bj = 0; bj < 2; ++bj) E.applymid(acc[ai][bj][m][0], acc[ai][bj][m][1], aux[m * 2 + bj]);
        __builtin_amdgcn_sched_barrier(0); } } }
    if (!midpoint) {
    const int row0 = cur.pm * BM + wr * 64 + fr, col0 = cur.pn * BM + wc * 32 + fq * 8;
    E.tile(cur.pm, cur.pn, col0);
    if constexpr (Epi::PRELOAD) {
#pragma unroll
      for (int ai = 0; ai < 2; ++ai) {
        typename Epi::Aux aux[8];
#pragma unroll
        for (int m = 0; m < 4; ++m)
#pragma unroll
          for (int bj = 0; bj < 2; ++bj) E.load(row0 + ai * HALF + m * 16, col0 + bj * HALF, aux[m * 2 + bj]);
        __builtin_amdgcn_sched_barrier(0);
#pragma unroll
        for (int m = 0; m < 4; ++m)
#pragma unroll
          for (int bj = 0; bj < 2; ++bj) E.apply(row0 + ai * HALF + m * 16, col0 + bj * HALF, bj, acc[ai][bj][m][0], acc[ai][bj][m][1], aux[m * 2 + bj]);
        __builtin_amdgcn_sched_barrier(0); }
    } else {
#pragma unroll
      for (int ai = 0; ai < 2; ++ai)
#pragma unroll
        for (int m = 0; m < 4; ++m)
#pragma unroll
          for (int bj = 0; bj < 2; ++bj) E(row0 + ai * HALF + m * 16, col0 + bj * HALF, acc[ai][bj][m][0], acc[ai][bj][m][1]); } }
    if (!has_next) break;
    if (!midpoint) {
#pragma unroll
    for (int a = 0; a < 2; ++a)
#pragma unroll
      for (int b = 0; b < 2; ++b)
#pragma unroll
        for (int m = 0; m < 4; ++m)
#pragma unroll
          for (int n = 0; n < 2; ++n) acc[a][b][m][n] = (f32x4){0.f, 0.f, 0.f, 0.f}; }
    cur = nxt; cA = nA; cB = nB; csub = nsub; ++ui;
  }
  PG8_WAIT_V(0);
  if (wr == 0) PG8_BAR;
  PG8_BAR;
#undef PG8_SA
#undef PG8_SB
#undef PG8_STAGE
#undef PG8_LDA
#undef PG8_LDB
#undef PG8_MMA
}

__device__ __forceinline__ u32x2 pack4(f32x4 v) { u32x2 r; r[0] = cvtpk(v[0], v[1]); r[1] = cvtpk(v[2], v[3]); return r; }
__device__ __forceinline__ u32x4 pack8v(f32x4 a, f32x4 b) { u32x4 r = {cvtpk(a[0], a[1]), cvtpk(a[2], a[3]), cvtpk(b[0], b[1]), cvtpk(b[2], b[3])}; return r; }
__device__ __forceinline__ f32x4 unpack4(u32x2 u) { f32x4 v; v[0] = __uint_as_float(u[0] << 16); v[1] = __uint_as_float(u[0] & 0xffff0000u); v[2] = __uint_as_float(u[1] << 16); v[3] = __uint_as_float(u[1] & 0xffff0000u); return v; }

struct EpiIn1 {
  static constexpr bool DUAL = false, PRELOAD = false;
  bf16_t* zrkv; float* zckv; float* misc; float* out;
  __device__ __forceinline__ void tile(int, int, int) {}
  __device__ __forceinline__ void operator()(int row, int col, f32x4 v, f32x4 w) const {
    if (col < 6144) { *(u32x4*)(zrkv + (size_t)row * 6144 + col) = pack8v(v, w); }
    else if (col < 6656) { const int c = col - 6144; float* zp = zckv + (size_t)row * 512 + c; *(f32x4*)zp = v; *(f32x4*)(zp + 4) = w;
      if (row < NPR) { float* op = out + OUT_CKV + (size_t)row * 512 + c; *(f32x4*)op = v; *(f32x4*)(op + 4) = w; } }
    else { const int c = col - 6656; float* mp = misc + (size_t)row * 512 + c; *(f32x4*)mp = v; *(f32x4*)(mp + 4) = w;
      if (row < NPR && c < 64) { float* op = out + OUT_KR + (size_t)row * 64 + c; *(f32x4*)op = v; *(f32x4*)(op + 4) = w; } }
  }
};
struct EpiIn2 {
  static constexpr bool DUAL = false, PRELOAD = false;
  bf16_t* zq; bf16_t* gate;
  __device__ __forceinline__ void tile(int, int, int) {}
  __device__ __forceinline__ void operator()(int row, int col, f32x4 v, f32x4 w) const {
    if (col < 3072) { *(u32x4*)(zq + (size_t)row * 3072 + col) = pack8v(v, w); }
    else { f32x4 s, t; for (int i = 0; i < 4; ++i) { s[i] = sigmoidf_(v[i]); t[i] = sigmoidf_(w[i]); } *(u32x4*)(gate + (size_t)row * 4096 + (col - 3072)) = pack8v(s, t); }
  }
};
struct EpiKV {
  static constexpr bool DUAL = false, PRELOAD = false;
  bf16_t* Kb; bf16_t* Vb; size_t krow0; int brow, bcol;
  __device__ __forceinline__ void tile(int pm, int pn, int) {
    const int h = pn;
    if (pm < 32) krow0 = (size_t)(pm * 16 + h) * 256;
    else if (pm < 64) { const int q = pm - 32; krow0 = 131072 + (size_t)((q >> 2) * 16 + h) * 1280 + (q & 3) * 256; }
    else krow0 = 131072 + (size_t)((pm - 64) * 16 + h) * 1280 + 1024;
    brow = pm * 256; bcol = pn * 256;
  }
  __device__ __forceinline__ void operator()(int row, int col, f32x4 v, f32x4 w) const {
    const int rl = row - brow, c = col - bcol;
    if (c < 128) *(u32x4*)(Kb + (krow0 + rl) * 192 + c) = pack8v(v, w);
    else *(u32x4*)(Vb + (krow0 + rl) * 128 + (c - 128)) = pack8v(v, w);
  }
};
struct Aux8 { u32x4 a, b; };
struct AuxF8 { f32x4 a, b; };
__device__ __forceinline__ void unpack8(u32x4 u, f32x4& lo, f32x4& hi) { lo = unpack4((u32x2){u[0], u[1]}); hi = unpack4((u32x2){u[2], u[3]}); }
struct EpiMerge {
  static constexpr bool DUAL = true, PRELOAD = true;
  typedef Aux8 Aux;
  bf16_t* merged; const bf16_t* gate;
  __device__ __forceinline__ void tile(int, int, int) {}
  __device__ __forceinline__ void loadmid(int row, int col, Aux& x) const {
    x.a = *(const u32x4*)(gate + (size_t)row * 4096 + col); x.b = *(const u32x4*)(gate + (size_t)row * 4096 + 2048 + col);
  }
  __device__ __forceinline__ void applymid(f32x4& v, f32x4& w, const Aux& x) const {
    f32x4 ga0, ga1, gb0, gb1; unpack8(x.a, ga0, ga1); unpack8(x.b, gb0, gb1);
#pragma unroll
    for (int i = 0; i < 4; ++i) { v[i] = v[i] * ga0[i] * __builtin_amdgcn_rcpf(gb0[i]); w[i] = w[i] * ga1[i] * __builtin_amdgcn_rcpf(gb1[i]); }
  }
  __device__ __forceinline__ void load(int row, int col, Aux& x) const { x.b = *(const u32x4*)(gate + (size_t)row * 4096 + 2048 + col); x.a = x.b; }
  __device__ __forceinline__ void apply(int row, int col, int, f32x4 v, f32x4 w, const Aux& x) const {
    f32x4 gb0, gb1; unpack8(x.b, gb0, gb1);
    *(u32x4*)(merged + (size_t)row * 2048 + col) = pack8v(gb0 * v, gb1 * w);
  }
};
struct EpiOut {
  static constexpr bool DUAL = false, PRELOAD = true;
  typedef AuxF8 Aux;
  const float* xp; const float* xs; const float* mod; bf16_t* X1; f32x4 g[2][2];
  __device__ __forceinline__ void tile(int pm, int, int col0) {
    const float* mg = mod + cond_of(pm * BM) * 12288 + 2 * 2048 + col0;
#pragma unroll
    for (int bj = 0; bj < 2; ++bj)
#pragma unroll
      for (int n = 0; n < 2; ++n) g[bj][n] = *(const f32x4*)(mg + bj * HALF + n * 4);
  }
  __device__ __forceinline__ void load(int row, int col, Aux& x) const {
    const float* xr = (row < NPR ? xp + (size_t)row * 2048 : xs + (size_t)(row - NPR) * 2048) + col; x.a = *(const f32x4*)xr; x.b = *(const f32x4*)(xr + 4);
  }
  __device__ __forceinline__ void apply(int row, int col, int bj, f32x4 v, f32x4 w, const Aux& x) const {
    *(u32x4*)(X1 + (size_t)row * 2048 + col) = pack8v(x.a + g[bj][0] * v, x.b + g[bj][1] * w);
  }
};
struct EpiFF1 {
  static constexpr bool DUAL = false, PRELOAD = false;
  bf16_t* ff;
  __device__ __forceinline__ void tile(int, int, int) {}
  __device__ __forceinline__ void operator()(int row, int col, f32x4 v, f32x4 w) const {
    f32x4 s, t; for (int i = 0; i < 4; ++i) { const float r = fmaxf(v[i], 0.f); s[i] = r * r; const float q = fmaxf(w[i], 0.f); t[i] = q * q; }
    *(u32x4*)(ff + (size_t)row * 8192 + col) = pack8v(s, t);
  }
};
struct EpiFF2 {
  static constexpr bool DUAL = false, PRELOAD = true;
  typedef u32x4 Aux;
  const float* mod; float* Y; const bf16_t* X1; f32x4 g[2][2];
  __device__ __forceinline__ void tile(int pm, int, int col0) {
    const float* mg = mod + cond_of(pm * BM) * 12288 + 5 * 2048 + col0;
#pragma unroll
    for (int bj = 0; bj < 2; ++bj)
#pragma unroll
      for (int n = 0; n < 2; ++n) g[bj][n] = *(const f32x4*)(mg + bj * HALF + n * 4);
  }
  __device__ __forceinline__ void load(int row, int col, Aux& x) const { x = *(const u32x4*)(X1 + (size_t)row * 2048 + col); }
  __device__ __forceinline__ void apply(int row, int col, int bj, f32x4 v, f32x4 w, const Aux& x) const {
    f32x4 a, b; unpack8(x, a, b);
    float* yp = Y + (size_t)row * 2048 + col; *(f32x4*)yp = a + g[bj][0] * v; *(f32x4*)(yp + 4) = b + g[bj][1] * w;
  }
};

__device__ __forceinline__ void convT_tile(const float* __restrict__ src, int Nsrc, int K, int k0, int srcn0, bf16_t* __restrict__ dst, int dstn0) {
  float* tile = (float*)smem;
  const int tid = otid();
  __syncthreads();
#pragma unroll
  for (int i = 0; i < 8; ++i) { const int idx = tid + i * 512, r = idx >> 6, c = idx & 63;
    tile[r * 65 + c] = srcn0 >= 0 ? src[(size_t)(k0 + r) * Nsrc + srcn0 + c] : 0.f; }
  __syncthreads();
  const int n = tid >> 3, ks = tid & 7;
  float v[8];
#pragma unroll
  for (int e = 0; e < 8; ++e) v[e] = tile[(ks * 8 + e) * 65 + n];
  u32x4 o = {cvtpk(v[0], v[1]), cvtpk(v[2], v[3]), cvtpk(v[4], v[5]), cvtpk(v[6], v[7])};
  *(u32x4*)(dst + (size_t)(dstn0 + n) * K + k0 + ks * 8) = o;
}
__device__ __forceinline__ int win_src_col(int nb) {
  if (nb < 96) return 3648 + (nb % 3) * 2048 + (nb / 3) * 64;
  if (nb < 104) return 3072 + (nb - 96) * 64;
  if (nb == 104) return 3584;
  if (nb < 111) return 9792 + (nb - 105) * 64;
  if (nb == 111) return -1;
  if (nb < 160) return (nb - 112) * 64;
  return 10176 + (nb - 160) * 64;
}

template <class F>
__device__ __forceinline__ void convT_tile4(const float* __restrict__ src, int Nsrc, int K, int k0, F srccol, bf16_t* __restrict__ dst, int dstn0) {
  float* tile = (float*)smem;
  const int tid = otid();
  __syncthreads();
  f32x4 v[8];
#pragma unroll
  for (int i = 0; i < 8; ++i) { const int idx = tid + i * 512, r = idx >> 6, c4 = idx & 63; const int sc = srccol(c4 >> 4);
    v[i] = sc >= 0 ? *(const f32x4*)(src + (size_t)(k0 + r) * Nsrc + sc + (c4 & 15) * 4) : (f32x4){0.f, 0.f, 0.f, 0.f}; }
#pragma unroll
  for (int i = 0; i < 8; ++i) { const int idx = tid + i * 512, r = idx >> 6, c4 = idx & 63; *(f32x4*)(tile + r * 260 + c4 * 4) = v[i]; }
  __syncthreads();
  const int n = tid >> 1, kh = tid & 1;
  bf16_t* dp = dst + (size_t)(dstn0 + n) * K + k0 + kh * 32;
#pragma unroll
  for (int q = 0; q < 4; ++q) { float x[8];
#pragma unroll
    for (int e = 0; e < 8; ++e) x[e] = tile[(kh * 32 + q * 8 + e) * 260 + n];
    u32x4 o = {cvtpk(x[0], x[1]), cvtpk(x[2], x[3]), cvtpk(x[4], x[5]), cvtpk(x[6], x[7])};
    *(u32x4*)(dp + q * 8) = o; }
}

struct CJob { const float* src; bf16_t* dst; int Nsrc, K, k0, sc, dstn0; };
template <class D>
__device__ __forceinline__ void conv_loop(D decode, const int njobs) {
  float* tile = (float*)smem;
  const int tid = otid(), c4 = tid & 63, r0 = tid >> 6, sb = c4 >> 4, n = tid >> 1, kh = tid & 1, G = gridDim.x;
  const int rho = n & 31, ii = rho & 15, nsrc = (n & ~31) + 8 * (ii >> 2) + 4 * (rho >> 4) + (ii & 3);
  int j = blockIdx.x;
  if (j >= njobs) return;
  CJob cur = decode(j, sb);
  f32x4 v[8];
#define CLOAD(J) do { _Pragma("unroll") for (int i = 0; i < 8; ++i) \
    v[i] = (J).sc >= 0 ? *(const f32x4*)((J).src + (size_t)((J).k0 + r0 + i * 8) * (J).Nsrc + (J).sc + (c4 & 15) * 4) : (f32x4){0.f, 0.f, 0.f, 0.f}; } while (0)
  CLOAD(cur);
  for (;;) {
    __syncthreads();
#pragma unroll
    for (int i = 0; i < 8; ++i) *(f32x4*)(tile + (r0 + i * 8) * 260 + c4 * 4) = v[i];
    __syncthreads();
    const int jn = j + G; const bool more = jn < njobs;
    CJob nxt = cur;
    if (more) { nxt = decode(jn, sb); CLOAD(nxt); }
    bf16_t* dp = cur.dst + (size_t)(cur.dstn0 + n) * cur.K + cur.k0 + kh * 32;
#pragma unroll
    for (int q = 0; q < 4; ++q) { float x[8];
#pragma unroll
      for (int e = 0; e < 8; ++e) x[e] = tile[(kh * 32 + q * 8 + e) * 260 + nsrc];
      u32x4 o = {cvtpk(x[0], x[1]), cvtpk(x[2], x[3]), cvtpk(x[4], x[5]), cvtpk(x[6], x[7])};
      *(u32x4*)(dp + q * 8) = o; }
    if (!more) break;
    cur = nxt; j = jn;
  }
#undef CLOAD
}

__device__ __forceinline__ void phase0(const Params& p) {
  const int tid = otid(), wid = tid >> 6, lane = tid & 63, G = gridDim.x;
  char* ws = p.ws;
  if (blockIdx.x == 0) {
    float* rope = (float*)(ws + OFF_ROPE);
    for (int i = tid; i < 1024; i += 512) { const int pos = i >> 4, pp = i & 15;
      const float inv = powf(10000.f, -(float)pp / 16.f); const float ang = (float)pos * inv;
      rope[i * 2] = cosf(ang); rope[i * 2 + 1] = sinf(ang); }
  }
  { const float* cckv = p.in[I_CCKV]; const float* kvn = p.in[I_KVNORM]; bf16_t* ckvn = (bf16_t*)(ws + OFF_CKVN);
    for (int r = blockIdx.x * 8 + wid; r < 2048; r += G * 8) {
      const float* xr = cckv + (size_t)r * 512 + lane * 8;
      f32x4 a = *(const f32x4*)xr, b = *(const f32x4*)(xr + 4);
      float ss = 0; for (int i = 0; i < 4; ++i) ss += a[i] * a[i] + b[i] * b[i];
      ss = wsum(ss); const float rs = rsqrtf(ss * (1.f / 512.f) + 1e-6f);
      const f32x4 g0 = *(const f32x4*)(kvn + lane * 8), g1 = *(const f32x4*)(kvn + lane * 8 + 4);
      a = a * rs * g0; b = b * rs * g1;
      u32x4 o = {cvtpk(a[0], a[1]), cvtpk(a[2], a[3]), cvtpk(b[0], b[1]), cvtpk(b[2], b[3])};
      *(u32x4*)(ckvn + (size_t)(NT + r) * 512 + lane * 8) = o;
    } }
  { float* sc = (float*)smem; float* mod = (float*)(ws + OFF_MOD);
    const float* wada = p.in[I_WADA];
    for (int cb = blockIdx.x; cb < 256; cb += G) {
      __syncthreads();
      for (int i = tid; i < 9 * 2048; i += 512) { const int g = i >> 11, k = i & 2047; const float c = g == 0 ? p.in[I_CCTX][k] : p.in[I_C][(g - 1) * 2048 + k]; sc[i] = c * sigmoidf_(c); }
      __syncthreads();
      const int c4 = tid % 12, r0 = tid / 12;
      f32x4 acc[9];
#pragma unroll
      for (int g = 0; g < 9; ++g) acc[g] = (f32x4){0.f, 0.f, 0.f, 0.f};
      if (r0 < 42) {
        const float* wp = wada + (size_t)cb * 48 + c4 * 4;
#pragma unroll 7
        for (int k = r0; k < 2048; k += 42) { const f32x4 w = *(const f32x4*)(wp + (size_t)k * 12288);
#pragma unroll
          for (int g = 0; g < 9; ++g) acc[g] += w * sc[g * 2048 + k]; }
      }
      __syncthreads();
      if (r0 < 42) {
#pragma unroll
        for (int g = 0; g < 9; ++g) *(f32x4*)(sc + (r0 * 9 + g) * 48 + c4 * 4) = acc[g];
      }
      __syncthreads();
      if (tid < 432) { const int g = tid / 48, c = tid % 48; float sum = 0.f;
        for (int r = 0; r < 42; ++r) sum += sc[(r * 9 + g) * 48 + c];
        mod[g * 12288 + cb * 48 + c] = sum + p.in[I_BADA][cb * 48 + c]; }
    } }
  conv_loop([&p, ws](int j, int sb) { CJob c;
    if (j < 1792) { const int nt4 = j >> 5, kb = j & 31; c.src = p.in[I_WIN]; c.dst = (bf16_t*)(ws + OFF_WTIN); c.Nsrc = 14272; c.K = 2048; c.k0 = kb * 64; c.sc = win_src_col(nt4 * 4 + sb); c.dstn0 = nt4 * 256; }
    else if (j < 1920) { const int jj = j - 1792, nt4 = jj >> 3, kb = jj & 7; c.src = p.in[I_WKVUP]; c.dst = (bf16_t*)(ws + OFF_WTKV); c.Nsrc = 4096; c.K = 512; c.k0 = kb * 64; c.sc = nt4 * 256 + sb * 64; c.dstn0 = nt4 * 256; }
    else { const int jj = j - 1920, m = jj >> 8, r = jj & 255, nt4 = r >> 5, kb = r & 31;
      c.src = m == 0 ? p.in[I_WBRM] : m == 1 ? p.in[I_WBRR] : p.in[I_WOUT];
      c.dst = (bf16_t*)(ws + (m == 0 ? OFF_WTBRM : m == 1 ? OFF_WTBRR : OFF_WTOUT));
      c.Nsrc = 2048; c.K = 2048; c.k0 = kb * 64; c.sc = nt4 * 256 + sb * 64; c.dstn0 = nt4 * 256; }
    return c; }, 2688);
}

template <bool SRC16>
__device__ __forceinline__ void norm_mod_phase(const float* xa, const float* xb  , const float* nw, const float* mod, int ish, int isc, bf16_t* dst) {
  const int tid = otid(), wid = tid >> 6, lane = tid & 63;
  const int stride = gridDim.x * 8;
  for (int t0 = blockIdx.x * 8 + wid; t0 < NT; t0 += 2 * stride) {
    f32x4 x[2][8]; float ss[2] = {0.f, 0.f};
#pragma unroll
    for (int u = 0; u < 2; ++u) { const int t = t0 + u * stride < NT ? t0 + u * stride : t0;
      if constexpr (SRC16) { const bf16_t* xr = (const bf16_t*)xa + (size_t)t * 2048;
#pragma unroll
        for (int i = 0; i < 8; ++i) x[u][i] = unpack4(*(const u32x2*)(xr + i * 256 + lane * 4)); }
      else { const float* xr = t < NPR ? xa + (size_t)t * 2048 : xb + (size_t)(t - NPR) * 2048;
#pragma unroll
        for (int i = 0; i < 8; ++i) x[u][i] = *(const f32x4*)(xr + i * 256 + lane * 4); } }
    __builtin_amdgcn_sched_barrier(0);
#pragma unroll
    for (int u = 0; u < 2; ++u) {
#pragma unroll
      for (int i = 0; i < 8; ++i) ss[u] += x[u][i][0] * x[u][i][0] + x[u][i][1] * x[u][i][1] + x[u][i][2] * x[u][i][2] + x[u][i][3] * x[u][i][3];
      ss[u] = wsum(ss[u]); }
#pragma unroll
    for (int u = 0; u < 2; ++u) { const int t = t0 + u * stride; if (t >= NT) break;
      const float* mg = mod + cond_of(t) * 12288; const float rs = rsqrtf(ss[u] * (1.f / 2048.f) + 1e-6f);
      f32x4 w[8], sv[8], sh[8];
#pragma unroll
      for (int i = 0; i < 8; ++i) { const int c = i * 256 + lane * 4; w[i] = *(const f32x4*)(nw + c); sv[i] = *(const f32x4*)(mg + isc * 2048 + c); sh[i] = *(const f32x4*)(mg + ish * 2048 + c); }
      __builtin_amdgcn_sched_barrier(0);
#pragma unroll
      for (int i = 0; i < 8; ++i) { const int c = i * 256 + lane * 4;
        const f32x4 h = x[u][i] * rs * w[i] * (1.f + sv[i]) + sh[i];
        *(u32x2*)(dst + (size_t)t * 2048 + c) = pack4(h); }
      __builtin_amdgcn_sched_barrier(0); }
  }
}

__device__ __forceinline__ float dpp_xor1(float x) { return __int_as_float(__builtin_amdgcn_update_dpp(0, __float_as_int(x), 0xB1, 0xf, 0xf, false)); }
__device__ __forceinline__ float dpp_xor2(float x) { return __int_as_float(__builtin_amdgcn_update_dpp(0, __float_as_int(x), 0x4E, 0xf, 0xf, false)); }

typedef float f32x2 __attribute__((ext_vector_type(2)));
__device__ __forceinline__ bf16x8 pack8(const float* x) { u32x4 w = {cvtpk(x[0], x[1]), cvtpk(x[2], x[3]), cvtpk(x[4], x[5]), cvtpk(x[6], x[7])}; return *reinterpret_cast<bf16x8*>(&w); }
__device__ __forceinline__ float tanh_(float x) { return 2.f * __builtin_amdgcn_rcpf(1.f + fexp(-2.f * x)) - 1.f; }

__device__ __forceinline__ void scan_phase(const Params& p) {
  int tid_ = threadIdx.x; asm volatile("" : "+v"(tid_));
  const int tid = tid_, wid = __builtin_amdgcn_readfirstlane(tid >> 6), lane = tid & 63, uw = wid & 3;
  float* lds = (float*)smem;
  float* resb = lds + 2 * 4 * 3072 + uw * 1024;
  const bf16_t* ZRKV = (const bf16_t*)(p.ws + OFF_ZRKV);
  const float* MISC = (const float*)(p.ws + OFF_MISC);
  float* BON = (float*)(p.ws + OFF_BON);
  bf16_t* YS = (bf16_t*)p.out;
  for (int item = blockIdx.x; item < 256; item += gridDim.x) {
    const bool samp = item < 128;
    const int T = samp ? 1024 : 256, rounds = samp ? 1 : 4, nch = T / 8;
    for (int rd = 0; rd < rounds; ++rd) {
      const int u = samp ? item * 4 + uw : (item - 128) * 16 + rd * 4 + uw;
      const int b = u >> 6, h = (u >> 1) & 31, d = u & 1, tb = samp ? NPR + b * 1024 : b * 256;
      if (wid >= 4) {
        const int hc = h * 64 + lane, fr = lane & 15, fq = lane >> 4;
        const float* cv = p.in[I_CONV];
        const float cr0 = cv[hc], cr1 = cv[6144 + hc], cr2 = cv[12288 + hc];
        const float ck0 = cv[2048 + hc], ck1 = cv[6144 + 2048 + hc], ck2 = cv[12288 + 2048 + hc];
        const float cv0 = cv[4096 + hc], cv1 = cv[6144 + 4096 + hc], cv2 = cv[12288 + 4096 + hc];
        const float kkw = p.in[I_KK][hc], kaw = p.in[I_KA][hc], rkw = p.in[I_RK][hc], w0c = p.in[I_W0][d * 2048 + hc], a0c = p.in[I_A0][d * 2048 + hc];
        bf16x8 bw[2][4], ba[2][4];
        { bf16_t* st16 = (bf16_t*)(lds + uw * 3072);
#pragma unroll 1
          for (int ps = 0; ps < 2; ++ps) {
            const float* src = (ps ? p.in[I_AUP] : p.in[I_WUP]) + (size_t)d * 64 * 2048 + hc;
#pragma unroll 8
            for (int j = 0; j < 64; ++j) st16[lane * 72 + j] = f2bf(src[(size_t)j * 2048]);
            asm volatile("s_waitcnt lgkmcnt(0)" ::: "memory"); __builtin_amdgcn_wave_barrier();
#pragma unroll
            for (int ks = 0; ks < 2; ++ks)
#pragma unroll
              for (int nt = 0; nt < 4; ++nt) { const bf16x8 f = *(const bf16x8*)(st16 + (nt * 16 + fr) * 72 + ks * 32 + fq * 8); if (ps) ba[ks][nt] = f; else bw[ks][nt] = f; }
            asm volatile("s_waitcnt lgkmcnt(0)" ::: "memory"); __builtin_amdgcn_wave_barrier();
          } }
        f32x4 mw[2][2], ma[2][2];
        float zr[10], zk[10], zv[10], nzr[10], nzk[10], nzv[10];
#define LOADM(c) do { const int plo_ = d ? T - 8 - (c) * 8 : (c) * 8; const float* mp_ = MISC + (size_t)(tb + plo_ + (fr & 7)) * 512 + d * 64 + fq * 8; \
          _Pragma("unroll") for (int ks = 0; ks < 2; ++ks) { mw[ks][0] = *(const f32x4*)(mp_ + 64 + ks * 32); mw[ks][1] = *(const f32x4*)(mp_ + 68 + ks * 32); \
            ma[ks][0] = *(const f32x4*)(mp_ + 192 + ks * 32); ma[ks][1] = *(const f32x4*)(mp_ + 196 + ks * 32); } } while (0)
#define LOADZ(c, R, Kk, V) do { const int plo_ = d ? T - 8 - (c) * 8 : (c) * 8; \
          _Pragma("unroll") for (int rr = 0; rr < 10; ++rr) { const int pos_ = plo_ - 1 + rr; const bool ok_ = pos_ >= 0 && pos_ < T; const int pc_ = ok_ ? pos_ : plo_; \
            const bf16_t* zc_ = ZRKV + (size_t)(tb + pc_) * 6144 + h * 192 + lane; const float a_ = bf2f(zc_[0]), b_ = bf2f(zc_[64]), c_ = bf2f(zc_[128]); \
            R[rr] = ok_ ? a_ : 0.f; Kk[rr] = ok_ ? b_ : 0.f; V[rr] = ok_ ? c_ : 0.f; } } while (0)
#define LORA() do { bf16x8 aw[2], aa[2]; \
          _Pragma("unroll") for (int ks = 0; ks < 2; ++ks) { float x[8], y[8]; \
            _Pragma("unroll") for (int e = 0; e < 4; ++e) { x[e] = tanh_(mw[ks][0][e]); x[4 + e] = tanh_(mw[ks][1][e]); y[e] = ma[ks][0][e]; y[4 + e] = ma[ks][1][e]; } \
            aw[ks] = pack8(x); aa[ks] = pack8(y); } \
          _Pragma("unroll") for (int nt = 0; nt < 4; ++nt) { f32x4 cw = {0.f, 0.f, 0.f, 0.f}, ca = {0.f, 0.f, 0.f, 0.f}; \
            cw = __builtin_amdgcn_mfma_f32_16x16x32_bf16(aw[0], bw[0][nt], cw, 0, 0, 0); cw = __builtin_amdgcn_mfma_f32_16x16x32_bf16(aw[1], bw[1][nt], cw, 0, 0, 0); \
            ca = __builtin_amdgcn_mfma_f32_16x16x32_bf16(aa[0], ba[0][nt], ca, 0, 0, 0); ca = __builtin_amdgcn_mfma_f32_16x16x32_bf16(aa[1], ba[1][nt], ca, 0, 0, 0); \
            if (fq < 2) { _Pragma("unroll") for (int e = 0; e < 4; ++e) { resb[(fq * 4 + e) * 128 + nt * 16 + fr] = cw[e]; resb[(fq * 4 + e) * 128 + 64 + nt * 16 + fr] = ca[e]; } } } \
          asm volatile("s_waitcnt lgkmcnt(0)" ::: "memory"); __builtin_amdgcn_wave_barrier(); } while (0)
        LOADM(0); LOADZ(0, zr, zk, zv); LORA();
        for (int it = 0; it <= nch; ++it) {
          if (it < nch) {
            float* buf = lds + ((it & 1) * 4 + uw) * 3072;
            const int plo = d ? T - 8 - it * 8 : it * 8;
            const int cn = it + 1 < nch ? it + 1 : it;
            LOADM(cn); LOADZ(cn, nzr, nzk, nzv);
            float uA[8], kkA[8], kkaA[8], kdA[8], rA[8];
#pragma unroll
            for (int pi = 0; pi < 8; ++pi) {
              const size_t t = tb + plo + pi;
              const float r = zr[pi] * cr0 + zr[pi + 1] * cr1 + zr[pi + 2] * cr2, k = zk[pi] * ck0 + zk[pi + 1] * ck1 + zk[pi + 2] * ck2, v = zv[pi] * cv0 + zv[pi + 1] * cv1 + zv[pi + 2] * cv2;
              const float kkv = k * kkw; const float ssq = wsum(kkv * kkv); const float kk = kkv * __builtin_amdgcn_rsqf(ssq + 1e-12f);
              const float accw = w0c + resb[pi * 128 + lane], acca = a0c + resb[pi * 128 + 64 + lane];
              uA[pi] = 0.87504273058139731f * sigmoidf_(accw);
              const float a = sigmoidf_(acca);
              const float kd = k * (1.f + (a - 1.f) * kaw);
              const float bon = rowsum16(r * kd * rkw);
              if ((lane & 15) == 0) BON[(((size_t)d * NT + t) * 32 + h) * 4 + (lane >> 4)] = bon;
              kkA[pi] = kk; kkaA[pi] = kk * a; kdA[pi] = kd; rA[pi] = r;
              buf[5 * 512 + pi * 64 + lane] = v;
            }
            { float L = 0.f, Pc = 1.f;
#define PSTEP(pi) do { const float Pp = Pc; L += uA[pi]; Pc = __builtin_amdgcn_exp2f(-L); const float Pi = __builtin_amdgcn_exp2f(L); \
                buf[1 * 512 + (pi) * 64 + lane] = kkA[pi] * Pp; buf[2 * 512 + (pi) * 64 + lane] = kkaA[pi] * Pi; \
                buf[3 * 512 + (pi) * 64 + lane] = kdA[pi] * Pi; buf[4 * 512 + (pi) * 64 + lane] = rA[pi] * Pc; } while (0)
              if (!d) { PSTEP(0); PSTEP(1); PSTEP(2); PSTEP(3); PSTEP(4); PSTEP(5); PSTEP(6); PSTEP(7); }
              else    { PSTEP(7); PSTEP(6); PSTEP(5); PSTEP(4); PSTEP(3); PSTEP(2); PSTEP(1); PSTEP(0); }
#undef PSTEP
              buf[0 * 512 + lane] = Pc; }
            asm volatile("s_waitcnt lgkmcnt(0)" ::: "memory"); __builtin_amdgcn_wave_barrier();
            LORA();
#pragma unroll
            for (int rr = 0; rr < 10; ++rr) { zr[rr] = nzr[rr]; zk[rr] = nzk[rr]; zv[rr] = nzv[rr]; }
          }
          asm volatile("s_waitcnt lgkmcnt(0)" ::: "memory"); __builtin_amdgcn_s_barrier(); asm volatile("" ::: "memory");
        }
#undef LOADM
#undef LOADZ
#undef LORA
      } else {
        const int vg = lane >> 2, kq = lane & 3;
        __builtin_amdgcn_s_setprio(2);
        f32x2 S[4][8];
        const size_t soff = ((size_t)((b * 2 + d) * 32 + h)) * 4096;
        if (samp) { const float* s0 = p.in[I_STATE] + soff;
#pragma unroll
          for (int a = 0; a < 4; ++a)
#pragma unroll
            for (int q = 0; q < 4; ++q) { const f32x4 x = *(const f32x4*)(s0 + (vg * 4 + a) * 64 + kq * 16 + q * 4); S[a][q * 2] = (f32x2){x[0], x[1]}; S[a][q * 2 + 1] = (f32x2){x[2], x[3]}; }
        } else {
#pragma unroll
          for (int a = 0; a < 4; ++a)
#pragma unroll
            for (int q = 0; q < 8; ++q) S[a][q] = (f32x2){0.f, 0.f};
        }
        for (int it = 0; it <= nch; ++it) {
          if (it >= 1) {
            const float* buf = lds + (((it - 1) & 1) * 4 + uw) * 3072;
            const int plo = d ? T - 8 - (it - 1) * 8 : (it - 1) * 8;
            f32x4 kkc[4], vvc;
            { const int slot0 = d ? 7 : 0; const float* bs0 = buf + slot0 * 64 + kq * 16;
#pragma unroll
              for (int q = 0; q < 4; ++q) kkc[q] = *(const f32x4*)(bs0 + 1 * 512 + q * 4);
              vvc = *(const f32x4*)(buf + 5 * 512 + slot0 * 64 + vg * 4); }
#pragma unroll 1
            for (int i = 0; i < 8; ++i) {
              const int slot = d ? 7 - i : i; const size_t t = tb + plo + slot;
              const int i1 = i < 7 ? i + 1 : 7, slotn = d ? 7 - i1 : i1;
              const float* bs = buf + slot * 64 + kq * 16; const float* bn = buf + slotn * 64 + kq * 16;
              f32x4 xka[4], xkd[4], xr[4], kkn[4], vvn;
#pragma unroll
              for (int q = 0; q < 4; ++q) xka[q] = *(const f32x4*)(bs + 2 * 512 + q * 4);
#pragma unroll
              for (int q = 0; q < 4; ++q) { xkd[q] = *(const f32x4*)(bs + 3 * 512 + q * 4); xr[q] = *(const f32x4*)(bs + 4 * 512 + q * 4); }
#pragma unroll
              for (int q = 0; q < 4; ++q) kkn[q] = *(const f32x4*)(bn + 1 * 512 + q * 4);
              vvn = *(const f32x4*)(buf + 5 * 512 + slotn * 64 + vg * 4);
              float sk[4];
#pragma unroll
              for (int a = 0; a < 4; ++a) {
                f32x2 sk2 = S[a][0] * (f32x2){kkc[0][0], kkc[0][1]}, sk3 = S[a][1] * (f32x2){kkc[0][2], kkc[0][3]};
#pragma unroll
                for (int q = 1; q < 4; ++q) { sk2 = __builtin_elementwise_fma(S[a][q * 2], (f32x2){kkc[q][0], kkc[q][1]}, sk2); sk3 = __builtin_elementwise_fma(S[a][q * 2 + 1], (f32x2){kkc[q][2], kkc[q][3]}, sk3); }
                sk2 += sk3;
                float x = sk2[0] + sk2[1]; x += dpp_xor1(x); x += dpp_xor2(x); sk[a] = x;
              }
              float y[4];
#pragma unroll
              for (int a = 0; a < 4; ++a) {
                const f32x2 nsk = (f32x2){-sk[a], -sk[a]}, va = (f32x2){vvc[a], vvc[a]};
                f32x2 y2 = (f32x2){0.f, 0.f}, y3 = (f32x2){0.f, 0.f};
#pragma unroll
                for (int q = 0; q < 4; ++q) {
                  f32x2 s0 = __builtin_elementwise_fma(nsk, (f32x2){xka[q][0], xka[q][1]}, S[a][q * 2]), s1 = __builtin_elementwise_fma(nsk, (f32x2){xka[q][2], xka[q][3]}, S[a][q * 2 + 1]);
                  s0 = __builtin_elementwise_fma(va, (f32x2){xkd[q][0], xkd[q][1]}, s0); s1 = __builtin_elementwise_fma(va, (f32x2){xkd[q][2], xkd[q][3]}, s1);
                  S[a][q * 2] = s0; S[a][q * 2 + 1] = s1;
                  y2 = __builtin_elementwise_fma(s0, (f32x2){xr[q][0], xr[q][1]}, y2); y3 = __builtin_elementwise_fma(s1, (f32x2){xr[q][2], xr[q][3]}, y3);
                }
                y2 += y3;
                float ya = y2[0] + y2[1]; ya += dpp_xor1(ya); ya += dpp_xor2(ya); y[a] = ya;
              }
              const float y01 = (kq & 1) ? y[1] : y[0], y23 = (kq & 1) ? y[3] : y[2];
              YS[((size_t)d * NT + t) * 2048 + h * 64 + lane] = f2bf((kq & 2) ? y23 : y01);
#pragma unroll
              for (int q = 0; q < 4; ++q) kkc[q] = kkn[q];
              vvc = vvn;
            }
#pragma unroll
            for (int q = 0; q < 4; ++q) { const f32x4 pt = *(const f32x4*)(buf + kq * 16 + q * 4);
#pragma unroll
              for (int a = 0; a < 4; ++a) { S[a][q * 2] = S[a][q * 2] * (f32x2){pt[0], pt[1]}; S[a][q * 2 + 1] = S[a][q * 2 + 1] * (f32x2){pt[2], pt[3]}; } }
          }
          asm volatile("s_waitcnt lgkmcnt(0)" ::: "memory"); __builtin_amdgcn_s_barrier(); asm volatile("" ::: "memory");
        }
        __builtin_amdgcn_s_setprio(0);
        if (!samp) { float* sf = p.out + OUT_ST + soff;
#pragma unroll
          for (int a = 0; a < 4; ++a)
#pragma unroll
            for (int q = 0; q < 4; ++q) { f32x4 x = {S[a][q * 2][0], S[a][q * 2][1], S[a][q * 2 + 1][0], S[a][q * 2 + 1][1]}; *(f32x4*)(sf + (vg * 4 + a) * 64 + kq * 16 + q * 4) = x; }
        }
      }
    }
  }
}

__device__ __forceinline__ void rwkv_fin_phase(const Params& p) {
  int tid_ = threadIdx.x; asm volatile("" : "+v"(tid_));
  const int tid = tid_, wid = __builtin_amdgcn_readfirstlane(tid >> 6), lane = tid & 63, fr = lane & 15, fq = lane >> 4, G = gridDim.x;
  const bf16_t* ZRKV = (const bf16_t*)(p.ws + OFF_ZRKV);
  const float* MISC = (const float*)(p.ws + OFF_MISC);
  const float* BON = (const float*)(p.ws + OFF_BON);
  const bf16_t* YS = (const bf16_t*)p.out;
  bf16_t* ORW = (bf16_t*)(p.ws + OFF_ORWKV);
  bf16_t* st16 = (bf16_t*)smem;
  float* cst = (float*)(smem + 17408);
  float* gt = (float*)(smem + 18688) + wid * (16 * 68);
  const int tt = lane >> 2, cg = lane & 3;
  for (int job = blockIdx.x; job < 256; job += G) {
    const int h = job & 31, tr = job >> 5;
    __syncthreads();
#pragma unroll 4
    for (int i = 0; i < 16; ++i) { const int idx = tid + i * 512, j = idx >> 6, c = idx & 63; st16[c * 136 + j] = f2bf(p.in[I_GUP][(size_t)j * 2048 + h * 64 + c]); }
    if (tid < 320) { const int w = tid >> 6, c = tid & 63; const int hc = h * 64 + c;
      cst[tid] = w == 0 ? p.in[I_LNXW][hc] : w == 1 ? p.in[I_LNXB][hc] : p.in[I_CONV][(w - 2) * 6144 + 4096 + hc]; }
    __syncthreads();
    bf16x8 bg[4][4];
#pragma unroll
    for (int ks = 0; ks < 4; ++ks)
#pragma unroll
      for (int nt = 0; nt < 4; ++nt) bg[ks][nt] = *(const bf16x8*)(st16 + (nt * 16 + fr) * 136 + ks * 32 + fq * 8);
#pragma unroll 1
    for (int i = 0; i < 16; ++i) {
      const int t0 = tr * 2048 + (wid * 16 + i) * 16;
      const size_t t = t0 + tt;
      const int pos = t < NPR ? (int)(t & 255) : (int)((t - NPR) & 1023), T = t < NPR ? 256 : 1024;
      const bool hasm = pos > 0, hasp = pos < T - 1;
      const bf16_t* y0p = YS + t * 2048 + h * 64 + cg * 16; const bf16_t* y1p = y0p + (size_t)NT * 2048;
      const bf16_t* zc = ZRKV + t * 6144 + h * 192 + 128 + cg * 16; const bf16_t* zm = hasm ? zc - 6144 : zc; const bf16_t* zp = hasp ? zc + 6144 : zc;
      u32x4 ya[2], yb[2], z0[2], z1[2], z2[2];
#pragma unroll
      for (int q = 0; q < 2; ++q) { ya[q] = *(const u32x4*)(y0p + q * 8); yb[q] = *(const u32x4*)(y1p + q * 8);
        z0[q] = *(const u32x4*)(zm + q * 8); z1[q] = *(const u32x4*)(zc + q * 8); z2[q] = *(const u32x4*)(zp + q * 8); }
      const f32x4 b0 = *(const f32x4*)(BON + (t * 32 + h) * 4), b1 = *(const f32x4*)(BON + (((size_t)NT + t) * 32 + h) * 4);
      f32x4 mx[4][2];
      { const float* mp = MISC + (size_t)(t0 + fr) * 512 + 320 + fq * 8;
#pragma unroll
        for (int ks = 0; ks < 4; ++ks) { mx[ks][0] = *(const f32x4*)(mp + ks * 32); mx[ks][1] = *(const f32x4*)(mp + ks * 32 + 4); } }
      __builtin_amdgcn_sched_barrier(0);
      bf16x8 ag[4];
#pragma unroll
      for (int ks = 0; ks < 4; ++ks) { float x[8];
#pragma unroll
        for (int e = 0; e < 4; ++e) { x[e] = sigmoidf_(mx[ks][0][e]); x[4 + e] = sigmoidf_(mx[ks][1][e]); }
        ag[ks] = pack8(x); }
#pragma unroll
      for (int nt = 0; nt < 4; ++nt) { f32x4 g = (f32x4){0.f, 0.f, 0.f, 0.f};
#pragma unroll
        for (int ks = 0; ks < 4; ++ks) g = __builtin_amdgcn_mfma_f32_16x16x32_bf16(ag[ks], bg[ks][nt], g, 0, 0, 0);
#pragma unroll
        for (int e = 0; e < 4; ++e) gt[(fq * 4 + e) * 68 + nt * 16 + fr] = g[e]; }
      asm volatile("s_waitcnt lgkmcnt(0)" ::: "memory"); __builtin_amdgcn_wave_barrier();
      float y[16]; float sum = 0.f;
#pragma unroll
      for (int q = 0; q < 2; ++q)
#pragma unroll
        for (int e = 0; e < 4; ++e) { const unsigned a = ya[q][e], b = yb[q][e];
          y[q * 8 + 2 * e] = __uint_as_float(a << 16) + __uint_as_float(b << 16); y[q * 8 + 2 * e + 1] = __uint_as_float(a & 0xffff0000u) + __uint_as_float(b & 0xffff0000u); }
#pragma unroll
      for (int c = 0; c < 16; ++c) sum += y[c];
      sum += dpp_xor1(sum); sum += dpp_xor2(sum);
      const float mu = sum * (1.f / 64.f);
      float qq = 0.f;
#pragma unroll
      for (int c = 0; c < 16; ++c) { y[c] -= mu; qq += y[c] * y[c]; }
      qq += dpp_xor1(qq); qq += dpp_xor2(qq);
      const float rstd = rsqrtf(qq * (1.f / 64.f) + 64e-5f);
      const float bon = (b0[0] + b0[1]) + (b0[2] + b0[3]) + (b1[0] + b1[1]) + (b1[2] + b1[3]);
      u32x4 outv[2];
#pragma unroll
      for (int q = 0; q < 2; ++q) { float o[8];
#pragma unroll
        for (int e4 = 0; e4 < 2; ++e4) { const int cb = q * 8 + e4 * 4;
          const f32x4 gv = *(const f32x4*)(gt + tt * 68 + cg * 16 + cb);
          const f32x4 lw = *(const f32x4*)(cst + 0 * 64 + cg * 16 + cb), lb = *(const f32x4*)(cst + 1 * 64 + cg * 16 + cb);
          const f32x4 k0 = *(const f32x4*)(cst + 2 * 64 + cg * 16 + cb), k1 = *(const f32x4*)(cst + 3 * 64 + cg * 16 + cb), k2 = *(const f32x4*)(cst + 4 * 64 + cg * 16 + cb);
#pragma unroll
          for (int e = 0; e < 4; ++e) { const int c = e4 * 4 + e; const int w = c >> 1;
            const unsigned um = z0[q][w], uc = z1[q][w], up = z2[q][w];
            const float vm = (c & 1) ? __uint_as_float(um & 0xffff0000u) : __uint_as_float(um << 16);
            const float vc = (c & 1) ? __uint_as_float(uc & 0xffff0000u) : __uint_as_float(uc << 16);
            const float vp = (c & 1) ? __uint_as_float(up & 0xffff0000u) : __uint_as_float(up << 16);
            const float v = (hasm ? vm : 0.f) * k0[e] + vc * k1[e] + (hasp ? vp : 0.f) * k2[e];
            o[c] = (y[q * 8 + c] * rstd * lw[e] + lb[e] + bon * v) * gv[e]; } }
        outv[q] = (u32x4){cvtpk(o[0], o[1]), cvtpk(o[2], o[3]), cvtpk(o[4], o[5]), cvtpk(o[6], o[7])}; }
      bf16_t* op = ORW + t * 2048 + h * 64 + cg * 16;
      *(u32x4*)op = outv[0]; *(u32x4*)(op + 8) = outv[1];
      asm volatile("s_waitcnt lgkmcnt(0)" ::: "memory"); __builtin_amdgcn_wave_barrier();
    }
  }
  { const float* zckv = (const float*)(p.ws + OFF_ZCKV); const float* kvn = p.in[I_KVNORM]; bf16_t* ckvn = (bf16_t*)(p.ws + OFF_CKVN);
    const f32x4 g0 = *(const f32x4*)(kvn + lane * 8), g1 = *(const f32x4*)(kvn + lane * 8 + 4);
    const int stride = G * 8;
    for (int r0 = blockIdx.x * 8 + wid; r0 < NT; r0 += 4 * stride) {
      f32x4 a[4], b[4];
#pragma unroll
      for (int u = 0; u < 4; ++u) { const int r = r0 + u * stride < NT ? r0 + u * stride : r0; const float* xr = zckv + (size_t)r * 512 + lane * 8; a[u] = *(const f32x4*)xr; b[u] = *(const f32x4*)(xr + 4); }
      __builtin_amdgcn_sched_barrier(0);
#pragma unroll
      for (int u = 0; u < 4; ++u) { const int r = r0 + u * stride; if (r >= NT) break;
        float ss = 0; for (int i = 0; i < 4; ++i) ss += a[u][i] * a[u][i] + b[u][i] * b[u][i];
        ss = wsum(ss); const float rs = rsqrtf(ss * (1.f / 512.f) + 1e-6f);
        const f32x4 x = a[u] * rs * g0, y = b[u] * rs * g1;
        u32x4 o = {cvtpk(x[0], x[1]), cvtpk(x[2], x[3]), cvtpk(y[0], y[1]), cvtpk(y[2], y[3])};
        *(u32x4*)(ckvn + (size_t)r * 512 + lane * 8) = o; }
    } }
}

__device__ __forceinline__ void kfin_phase(const Params& p) {
  const int tid = otid(), wid = tid >> 6, lane = tid & 63, fr = lane & 15, fq = lane >> 4;
  bf16_t* Kb = (bf16_t*)(p.ws + OFF_K);
  const float* MISC = (const float*)(p.ws + OFF_MISC);
  const float* rope = (const float*)(p.ws + OFF_ROPE);
  const float* knw = p.in[I_KNORM];
  const f32x4 gn0 = *(const f32x4*)(knw + fr * 8), gn1 = *(const f32x4*)(knw + fr * 8 + 4), gr = *(const f32x4*)(knw + 128 + fr * 4);
  const int axis = fr >> 3, second = (fr >> 2) & 1, pp0 = (fr & 3) * 4;
  const int njobs = 18432 * 4, stride = gridDim.x * 8;
  for (int job0 = blockIdx.x * 8 + wid; job0 < njobs; job0 += stride * 4) {
    u32x4 raw[4]; f32x4 krv[4]; bf16_t* kp[4]; int tposv[4]; bool ropev[4], valid[4];
#pragma unroll
    for (int u = 0; u < 4; ++u) {
      const int job = job0 + u * stride; valid[u] = job < njobs; const int jc = valid[u] ? job : job0;
      const int r = jc >> 2, h = (jc & 3) * 4 + fq;
      size_t krow; const float* krp; ropev[u] = false; tposv[u] = 0;
      if (r < NPR) { krow = (size_t)((r >> 8) * 16 + h) * 256 + (r & 255); krp = MISC + (size_t)r * 512; }
      else if (r < NT) { const int rr = r - NPR; krow = 131072 + (size_t)((rr >> 10) * 16 + h) * 1280 + (rr & 1023); krp = MISC + (size_t)r * 512; ropev[u] = true; tposv[u] = rr & 1023; }
      else { const int rr = r - NT; krow = 131072 + (size_t)((rr >> 8) * 16 + h) * 1280 + 1024 + (rr & 255); krp = p.in[I_CKR] + (size_t)rr * 64; }
      kp[u] = Kb + krow * 192;
      raw[u] = *(const u32x4*)(kp[u] + fr * 8); krv[u] = *(const f32x4*)(krp + fr * 4);
    }
    __builtin_amdgcn_sched_barrier(0);
#pragma unroll
    for (int u = 0; u < 4; ++u) {
      float n[8];
#pragma unroll
      for (int i = 0; i < 4; ++i) { n[2 * i] = __uint_as_float(raw[u][i] << 16); n[2 * i + 1] = __uint_as_float(raw[u][i] & 0xffff0000u); }
      float ss = 0.f;
#pragma unroll
      for (int i = 0; i < 8; ++i) ss += n[i] * n[i];
#pragma unroll
      for (int i = 0; i < 4; ++i) ss += krv[u][i] * krv[u][i];
      ss = rowsum16(ss);
      const float rs = __builtin_amdgcn_rsqf(ss * (1.f / 192.f) + 1e-6f);
      u32x4 o = {cvtpk(n[0] * rs * gn0[0], n[1] * rs * gn0[1]), cvtpk(n[2] * rs * gn0[2], n[3] * rs * gn0[3]),
                 cvtpk(n[4] * rs * gn1[0], n[5] * rs * gn1[1]), cvtpk(n[6] * rs * gn1[2], n[7] * rs * gn1[3])};
      f32x4 x = krv[u] * rs * gr, pr;
#pragma unroll
      for (int i = 0; i < 4; ++i) pr[i] = __shfl_xor(x[i], 4);
      if (ropev[u]) { const int pos = axis ? (tposv[u] & 63) : (tposv[u] >> 6);
#pragma unroll
        for (int i = 0; i < 4; ++i) { const float cs = rope[(pos * 16 + pp0 + i) * 2], sn = rope[(pos * 16 + pp0 + i) * 2 + 1];
          x[i] = second ? x[i] * cs + pr[i] * sn : x[i] * cs - pr[i] * sn; } }
      if (valid[u]) { *(u32x4*)(kp[u] + fr * 8) = o; u32x2 ro = {cvtpk(x[0], x[1]), cvtpk(x[2], x[3])}; *(u32x2*)(kp[u] + 128 + fr * 4) = ro; }
    }
  }
}

constexpr float ATT_SCALE = 0.07216878364870322f;
constexpr float ATT_THR = 8.f;
constexpr int SHM_V = 64 * 128 * 2, SHM_K = 64 * 192 * 2;
#define KSWZ(row, colB) ((row) * 384 + ((colB) ^ (((row) & 7) << 4)))
#define SBAR() __builtin_amdgcn_sched_barrier(0)
__device__ __forceinline__ int crow(int r, int hi) { return (r & 3) + 8 * (r >> 2) + 4 * hi; }
__device__ __forceinline__ void partialSM(f32x16& p0, f32x16& p1, float& m_reg, float& mn, float& alpha) {
  constexpr float C = ATT_SCALE * 1.4426950408889634f;
  float pmax = p0[0]; for (int r = 1; r < 16; ++r) pmax = fmaxf(pmax, p0[r]); for (int r = 0; r < 16; ++r) pmax = fmaxf(pmax, p1[r]);
  { auto rr = __builtin_amdgcn_permlane32_swap(__float_as_uint(pmax), __float_as_uint(pmax), false, false);
    pmax = fmaxf(__uint_as_float(rr[0]), __uint_as_float(rr[1])); }
  if (__builtin_expect(__all(pmax - m_reg <= ATT_THR / ATT_SCALE), 1)) { mn = m_reg; alpha = 1.f; }
  else { mn = fmaxf(m_reg, pmax); alpha = __builtin_amdgcn_exp2f((m_reg - mn) * C); m_reg = mn; }
  float mnC = -mn * C;
  for (int r = 0; r < 16; ++r) p0[r] = fmaf(p0[r], C, mnC); for (int r = 0; r < 16; ++r) p1[r] = fmaf(p1[r], C, mnC);
  for (int r = 0; r < 16; ++r) p0[r] = __builtin_amdgcn_exp2f(p0[r]);
}
__device__ __forceinline__ void finishSM(f32x16& p0, f32x16& p1, float alpha, float& l_reg, bf16x8& pa0, bf16x8& pa1, bf16x8& pa2, bf16x8& pa3) {
  for (int r = 0; r < 16; ++r) p1[r] = __builtin_amdgcn_exp2f(p1[r]);
  float ps = 0; for (int r = 0; r < 16; ++r) ps += p0[r]; for (int r = 0; r < 16; ++r) ps += p1[r];
  { auto rr = __builtin_amdgcn_permlane32_swap(__float_as_uint(ps), __float_as_uint(ps), false, false);
    ps = __uint_as_float(rr[0]) + __uint_as_float(rr[1]); }
  l_reg = l_reg * alpha + ps;
#define PK4(P, BASE, OUT) do { unsigned a0 = cvtpk(P[BASE + 0], P[BASE + 1]), a1 = cvtpk(P[BASE + 2], P[BASE + 3]);   \
    unsigned b0 = cvtpk(P[BASE + 4], P[BASE + 5]), b1 = cvtpk(P[BASE + 6], P[BASE + 7]);                              \
    auto r0 = __builtin_amdgcn_permlane32_swap(a0, b0, false, false); auto r1 = __builtin_amdgcn_permlane32_swap(a1, b1, false, false); \
    u32x4 w = {r0[0], r1[0], r0[1], r1[1]}; OUT = *reinterpret_cast<bf16x8*>(&w); } while (0)
  PK4(p0, 0, pa0); PK4(p0, 8, pa1); PK4(p1, 0, pa2); PK4(p1, 8, pa3);
#undef PK4
}
__device__ __forceinline__ void qkt(f32x16& p0, f32x16& p1, const char* Ks, const bf16x8* qr, int r32, int hi) {
  p0 = f32x16{}; p1 = f32x16{};
  bf16x8 ka[3], kb[3];
#define KLD(d0, slot) do { const int cb_ = ((d0) * 16 + hi * 8) * 2; ka[slot] = *reinterpret_cast<const bf16x8*>(Ks + KSWZ(r32, cb_)); kb[slot] = *reinterpret_cast<const bf16x8*>(Ks + KSWZ(32 + r32, cb_)); } while (0)
  KLD(0, 0); KLD(1, 1); __builtin_amdgcn_sched_barrier(0);
#pragma unroll
  for (int d0 = 0; d0 < 12; ++d0) {
    if (d0 + 2 < 12) KLD(d0 + 2, (d0 + 2) % 3);
    __builtin_amdgcn_sched_barrier(0);
    p0 = __builtin_amdgcn_mfma_f32_32x32x16_bf16(ka[d0 % 3], qr[d0], p0, 0, 0, 0);
    p1 = __builtin_amdgcn_mfma_f32_32x32x16_bf16(kb[d0 % 3], qr[d0], p1, 0, 0, 0);
    __builtin_amdgcn_sched_barrier(0); }
#undef KLD
}
__device__ __forceinline__ int v_st(int k, int c) { const int kk = (k & ~0xC) | ((k & 4) << 1) | ((k & 8) >> 1); return ((kk >> 3) * 4 + (c >> 5)) * 512 + ((kk & 7) * 32 + (c & 31)) * 2; }
__device__ __forceinline__ int v_rd_base(int lane) { return ((lane & 3) << 3) | (((lane >> 2) & 3) << 6) | (((lane >> 4) & 1) << 5) | (((lane >> 5) & 1) << 8); }
constexpr int v_rd_off(int d0, int ks, int half) { return d0 * 512 + ks * 4096 + half * 2048; }
template <int OFF> __device__ __forceinline__ s16x4 tr_read(int vb) {
  s16x4 r; asm volatile("ds_read_b64_tr_b16 %0, %1 offset:%2" : "=&v"(r) : "v"(vb), "i"(OFF) : "memory"); return r;
}
template <int D0> __device__ __forceinline__ void pv_one(f32x16& od, int vb, bf16x8 pa0, bf16x8 pa1, bf16x8 pa2, bf16x8 pa3) {
  const s16x4 l0 = tr_read<v_rd_off(D0, 0, 0)>(vb), h0 = tr_read<v_rd_off(D0, 0, 1)>(vb), l1 = tr_read<v_rd_off(D0, 1, 0)>(vb), h1 = tr_read<v_rd_off(D0, 1, 1)>(vb);
  const s16x4 l2 = tr_read<v_rd_off(D0, 2, 0)>(vb), h2 = tr_read<v_rd_off(D0, 2, 1)>(vb), l3 = tr_read<v_rd_off(D0, 3, 0)>(vb), h3 = tr_read<v_rd_off(D0, 3, 1)>(vb);
  asm volatile("s_waitcnt lgkmcnt(0)" ::: "memory"); SBAR();
#define PK(L, H) (bf16x8){L[0], L[1], L[2], L[3], H[0], H[1], H[2], H[3]}
  od = __builtin_amdgcn_mfma_f32_32x32x16_bf16(pa0, PK(l0, h0), od, 0, 0, 0);
  od = __builtin_amdgcn_mfma_f32_32x32x16_bf16(pa1, PK(l1, h1), od, 0, 0, 0);
  od = __builtin_amdgcn_mfma_f32_32x32x16_bf16(pa2, PK(l2, h2), od, 0, 0, 0);
  od = __builtin_amdgcn_mfma_f32_32x32x16_bf16(pa3, PK(l3, h3), od, 0, 0, 0);
#undef PK
}
__device__ __forceinline__ void pv_d0(f32x16* o, int vb, bf16x8 pa0, bf16x8 pa1, bf16x8 pa2, bf16x8 pa3) {
  pv_one<0>(o[0], vb, pa0, pa1, pa2, pa3); pv_one<1>(o[1], vb, pa0, pa1, pa2, pa3); pv_one<2>(o[2], vb, pa0, pa1, pa2, pa3); pv_one<3>(o[3], vb, pa0, pa1, pa2, pa3);
}

__device__ __forceinline__ void attn_unit(const bf16_t* __restrict__ Qb, const bf16_t* __restrict__ Kh, const bf16_t* __restrict__ Vh, bf16_t* __restrict__ Ob,
                                          const int seq, const float* __restrict__ qnw, const bool dorope, const int tpos0, const float* __restrict__ rope) {
  char* lds = smem;
  int tid_ = threadIdx.x; asm volatile("" : "+v"(tid_));
  const int tid = tid_, wid = tid >> 6, lane = tid & 63, r32 = lane & 31, hi = lane >> 5;
  char* V_lds = lds; char* K_lds = lds + 2 * SHM_V;
  float* wsf = (float*)(lds + 2 * SHM_V + 2 * SHM_K) + wid * 64; float* li_l = wsf; float* al_l = wsf + 32;
  float m_reg = -1e30f, l_reg = 0; bf16x8 qr[12];
  __syncthreads();
  {
    const bf16_t* Qw = Qb + (size_t)(wid * 32 + r32) * 3072 + hi * 8;
    float ss = 0.f;
#pragma unroll
    for (int d0 = 0; d0 < 12; ++d0) { const bf16x8 raw = *(const bf16x8*)(Qw + d0 * 16);
#pragma unroll
      for (int e = 0; e < 8; ++e) { const float x = bf2f((bf16_t)raw[e]); ss += x * x; } }
    ss += __shfl_xor(ss, 32);
    const float rs = rsqrtf(ss * (1.f / 192.f) + 1e-6f);
    const int tpos = tpos0 + wid * 32 + r32;
    asm volatile("" ::: "memory");
#pragma unroll
    for (int d0 = 0; d0 < 12; d0 += 2) {
      const bf16x8 ra = *(const volatile bf16x8*)(Qw + d0 * 16), rb = *(const volatile bf16x8*)(Qw + d0 * 16 + 16);
      float xa[8], xb[8];
#pragma unroll
      for (int e = 0; e < 8; ++e) { xa[e] = bf2f((bf16_t)ra[e]) * rs * qnw[d0 * 16 + hi * 8 + e]; xb[e] = bf2f((bf16_t)rb[e]) * rs * qnw[(d0 + 1) * 16 + hi * 8 + e]; }
      if (d0 >= 8 && dorope) {
        const int pos = d0 == 8 ? (tpos >> 6) : (tpos & 63);
#pragma unroll
        for (int e = 0; e < 8; ++e) { const int pp = hi * 8 + e; const float cs = rope[(pos * 16 + pp) * 2], sn = rope[(pos * 16 + pp) * 2 + 1];
          const float x1 = xa[e], x2 = xb[e]; xa[e] = x1 * cs - x2 * sn; xb[e] = x2 * cs + x1 * sn; }
      }
      u32x4 wa = {cvtpk(xa[0], xa[1]), cvtpk(xa[2], xa[3]), cvtpk(xa[4], xa[5]), cvtpk(xa[6], xa[7])};
      u32x4 wb = {cvtpk(xb[0], xb[1]), cvtpk(xb[2], xb[3]), cvtpk(xb[4], xb[5]), cvtpk(xb[6], xb[7])};
      qr[d0] = *reinterpret_cast<bf16x8*>(&wa); qr[d0 + 1] = *reinterpret_cast<bf16x8*>(&wb);
    }
  }
  f32x16 o[4] = {};
  const int sr = tid >> 4, sc = (tid & 15) * 8, vst0 = v_st(sr, sc), vst1 = v_st(32 + sr, sc);
  const int kc0 = tid, kc1 = tid + 512, kc2 = tid + 1024;
  const int kr0 = kc0 / 24, kq0 = kc0 % 24, kr1 = kc1 / 24, kq1 = kc1 % 24, kr2 = kc2 / 24, kq2 = kc2 % 24;
  const int vb0 = (int)(uintptr_t)V_lds + v_rd_base(lane);
  bf16x8 vs0, vs1, ks0, ks1, ks2;
#define SLOAD(k0) do { vs0 = *(const bf16x8*)(Vh + (size_t)((k0) + sr) * 128 + sc); vs1 = *(const bf16x8*)(Vh + (size_t)((k0) + 32 + sr) * 128 + sc); \
    ks0 = *(const bf16x8*)(Kh + (size_t)((k0) + kr0) * 192 + kq0 * 8); ks1 = *(const bf16x8*)(Kh + (size_t)((k0) + kr1) * 192 + kq1 * 8); \
    ks2 = *(const bf16x8*)(Kh + (size_t)((k0) + kr2) * 192 + kq2 * 8); } while (0)
#define SWRITE(b) do { *(bf16x8*)(V_lds + (b) * SHM_V + vst0) = vs0; *(bf16x8*)(V_lds + (b) * SHM_V + vst1) = vs1; \
    *(bf16x8*)(K_lds + (b) * SHM_K + KSWZ(kr0, kq0 * 16)) = ks0; *(bf16x8*)(K_lds + (b) * SHM_K + KSWZ(kr1, kq1 * 16)) = ks1; \
    *(bf16x8*)(K_lds + (b) * SHM_K + KSWZ(kr2, kq2 * 16)) = ks2; } while (0)
  const int NTL = seq / 64;
  SLOAD(0); SWRITE(0);
  f32x16 p0, p1; float mn, al; bf16x8 pa0, pa1, pa2, pa3;
  for (int j = 0; j < NTL; ++j) {
    const int bsel = j & 1;
    __syncthreads();
    if (j + 1 < NTL) SLOAD((j + 1) * 64);
    SBAR();
    qkt(p0, p1, K_lds + bsel * SHM_K, qr, r32, hi);
    partialSM(p0, p1, m_reg, mn, al);
    if (__any(al < 1.f)) { if (hi == 0) al_l[r32] = al; asm volatile("s_waitcnt lgkmcnt(0)" ::: "memory");
#pragma unroll
      for (int d = 0; d < 4; ++d)
#pragma unroll
        for (int r = 0; r < 16; ++r) o[d][r] *= al_l[crow(r, hi)]; }
    finishSM(p0, p1, al, l_reg, pa0, pa1, pa2, pa3); SBAR();
    pv_d0(o, vb0 + bsel * SHM_V, pa0, pa1, pa2, pa3);
    if (j + 1 < NTL) SWRITE(bsel ^ 1);
  }
  if (hi == 0) li_l[r32] = l_reg; asm volatile("s_waitcnt lgkmcnt(0)" ::: "memory");
  float rli[16];
#pragma unroll
  for (int r = 0; r < 16; ++r) rli[r] = __builtin_amdgcn_rcpf(li_l[crow(r, hi)]);
  bf16_t* Ow = Ob + (size_t)(wid * 32) * 2048;
#pragma unroll
  for (int r = 0; r < 16; ++r) { const int orow = crow(r, hi);
#pragma unroll
    for (int d0 = 0; d0 < 4; ++d0) Ow[(size_t)orow * 2048 + d0 * 32 + r32] = f2bf(o[d0][r] * rli[r]); }
#undef SLOAD
#undef SWRITE
}

__device__ __forceinline__ void attn_phase(const Params& p) {
  const bf16_t* ZQ = (const bf16_t*)(p.ws + OFF_ZQ); const bf16_t* Kb = (const bf16_t*)(p.ws + OFF_K); const bf16_t* Vb = (const bf16_t*)(p.ws + OFF_V);
  bf16_t* OM = (bf16_t*)(p.ws + OFF_OMLA); const float* rope = (const float*)(p.ws + OFF_ROPE);
  for (int u = blockIdx.x; u < 1024; u += gridDim.x) {
    if (u < 512) { const int b = u >> 6, h = (u >> 2) & 15, qb = u & 3; const size_t t0 = NPR + b * 1024 + qb * 256, kr = 131072 + (size_t)(b * 16 + h) * 1280;
      attn_unit(ZQ + t0 * 3072 + h * 192, Kb + kr * 192, Vb + kr * 128, OM + t0 * 2048 + h * 128, 1280, p.in[I_QNORM], true, qb * 256, rope); }
    else { const int up = u - 512, b = up >> 4, h = up & 15; const size_t t0 = b * 256, kr = (size_t)(b * 16 + h) * 256;
      attn_unit(ZQ + t0 * 3072 + h * 192, Kb + kr * 192, Vb + kr * 128, OM + t0 * 2048 + h * 128, 256, p.in[I_QNORM], false, 0, rope); }
  }
}

__device__ __forceinline__ void ffconv_phase(const Params& p) {
  conv_loop([&p](int j, int sb) { CJob c;
    if (j < 1024) { const int nt4 = j >> 5, kb = j & 31; c.src = p.in[I_WFFIN]; c.dst = (bf16_t*)(p.ws + OFF_WTFFIN); c.Nsrc = 8192; c.K = 2048; c.k0 = kb * 64; c.sc = nt4 * 256 + sb * 64; c.dstn0 = nt4 * 256; }
    else { const int jj = j - 1024, nt4 = jj >> 7, kb = jj & 127; c.src = p.in[I_WFFOUT]; c.dst = (bf16_t*)(p.ws + OFF_WTFFOUT); c.Nsrc = 2048; c.K = 8192; c.k0 = kb * 64; c.sc = nt4 * 256 + sb * 64; c.dstn0 = nt4 * 256; }
    return c; }, 2048);
}

#define XB_TMO      128
#define XB_XCNT(j)  (256  + 64 * (j))
#define XB_XSUB(j)  (1280 + 64 * (j))
#define XB_XGEN(j)  (2304 + 64 * (j))
#define XB_TOP      3328
#define XB_TOPGEN   3392
#define XCD_BAR_WORDS 3456
#define XB_SPIN_CAP (1u << 18)
__device__ __forceinline__ unsigned xb_ld(unsigned* p)              { return __hip_atomic_load(p, __ATOMIC_RELAXED, __HIP_MEMORY_SCOPE_AGENT); }
__device__ __forceinline__ unsigned xb_add(unsigned* p, unsigned v) { return __hip_atomic_fetch_add(p, v, __ATOMIC_RELAXED, __HIP_MEMORY_SCOPE_AGENT); }
__device__ __forceinline__ unsigned xb_xcc_id() { return (unsigned)__builtin_amdgcn_s_getreg((3 << 11) | 20) & 0xFu; }
#define XB_SPIN(cond, bar) do { unsigned _sp = 0; while (cond) { __builtin_amdgcn_s_sleep(1); \
    if ((++_sp & 255u) == 0u) { if (xb_ld(&(bar)[XB_TMO])) break; if (_sp > XB_SPIN_CAP) { atomicAdd(&(bar)[XB_TMO], 1u); break; } } } } while (0)
struct XcdBarrier { unsigned* bar; unsigned x; volatile LAS unsigned* st; };
__device__ __forceinline__ XcdBarrier xcd_barrier_post(unsigned* bar, volatile LAS unsigned* st) {
  XcdBarrier b; b.bar = bar; b.x = xb_xcc_id(); b.st = st;
  if (threadIdx.x == 0) (void)xb_add(&bar[XB_XCNT(b.x)], 1u);
  return b;
}
__device__ __forceinline__ void xcd_barrier_complete(unsigned* bar, unsigned x, unsigned& nloc, unsigned& nx) {
  const unsigned G = gridDim.x * gridDim.y * gridDim.z;
  unsigned sum, cnt, mine, sp = 0u;
  for (;;) {
    sum = 0u; cnt = 0u; mine = 0u;
#pragma unroll
    for (unsigned j = 0; j < 16; ++j) { const unsigned c = xb_ld(&bar[XB_XCNT(j)]); sum += c; cnt += (c > 0u) ? 1u : 0u; mine = (j == x) ? c : mine; }
    if (sum == G) break;
    __builtin_amdgcn_s_sleep(1);
    if ((++sp & 255u) == 0u) { if (xb_ld(&bar[XB_TMO])) break; if (sp > XB_SPIN_CAP) { atomicAdd(&bar[XB_TMO], 1u); break; } }
  }
  nloc = mine > 0u ? mine : 1u; nx = cnt > 0u ? cnt : 1u;
}
__device__ __forceinline__ void xcd_barrier(const XcdBarrier& b) {
  asm volatile("s_waitcnt vmcnt(0)" ::: "memory");
  __syncthreads();
  if (threadIdx.x == 0) {
    unsigned* bar = b.bar;
    __builtin_amdgcn_s_waitcnt(0);
    unsigned nloc = b.st[0], nx = b.st[1];
    if (nloc == 0u) { xcd_barrier_complete(bar, b.x, nloc, nx); b.st[0] = nloc; b.st[1] = nx; }
    const unsigned old = xb_add(&bar[XB_XSUB(b.x)], 1u);
    const unsigned gen = old / nloc;
    if (old + 1u == (gen + 1u) * nloc) {
      __builtin_amdgcn_fence(__ATOMIC_RELEASE, "agent");
      asm volatile("s_waitcnt vmcnt(0)" ::: "memory");
      const unsigned og = xb_add(&bar[XB_TOP], 1u);
      const unsigned tg = og / nx;
      if (og + 1u == (tg + 1u) * nx) xb_add(&bar[XB_TOPGEN], 1u);
      else XB_SPIN(xb_ld(&bar[XB_TOPGEN]) == tg, bar);
      __builtin_amdgcn_fence(__ATOMIC_ACQUIRE, "agent");
      xb_add(&bar[XB_XGEN(b.x)], 1u);
      asm volatile("s_waitcnt vmcnt(0)" ::: "memory");
    } else {
      XB_SPIN(xb_ld(&bar[XB_XGEN(b.x)]) == gen, bar);
      __builtin_amdgcn_fence(__ATOMIC_ACQUIRE, "agent");
      asm volatile("s_waitcnt vmcnt(0)" ::: "memory");
    }
  }
  __syncthreads();
}

__global__ void __launch_bounds__(512, 2) fwd_megakernel(Params p, int ph_lo, int ph_hi) {
  cg::grid_group grid = cg::this_grid();
  char* ws = p.ws;
  __shared__ uint4 xb_words;
  if (threadIdx.x == 0) xb_words = make_uint4(0u, 0u, 0u, 0u);
  __syncthreads();
  const XcdBarrier xb = xcd_barrier_post((unsigned*)(ws + OFF_XBAR), (volatile LAS unsigned*)&xb_words);
  if (ph_hi > 1000) grid.sync();
  const float* mod = (const float*)(ws + OFF_MOD);
#ifndef PHMASK
#define PHMASK 0xffff
#endif
#define ON(n) ((PHMASK >> (n)) & 1)
#ifndef DUPMASK
#define DUPMASK 0
#endif
#define PHASE(n, ...) if (ON(n) && ph_lo <= (n) && (n) < ph_hi) { __VA_ARGS__; if ((n) + 1 < ph_hi) xcd_barrier(xb); }
  PHASE(0, phase0(p))
  PHASE(1, norm_mod_phase<false>(p.in[I_XP], p.in[I_XS], p.in[I_NORM1], mod, 0, 1, (bf16_t*)(ws + OFF_H)))
  PHASE(2, { EpiIn1 e{(bf16_t*)(ws + OFF_ZRKV), (float*)(ws + OFF_ZCKV), (float*)(ws + OFF_MISC), p.out};
             gemm_phase((const bf16_t*)(ws + OFF_H), (const bf16_t*)(ws + OFF_WTIN), 2048, 64, 28, e); })
  PHASE(3, scan_phase(p))
  PHASE(4, rwkv_fin_phase(p))
  PHASE(5, { EpiIn2 e{(bf16_t*)(ws + OFF_ZQ), (bf16_t*)p.out};
             gemm_phase((const bf16_t*)(ws + OFF_H), (const bf16_t*)(ws + OFF_WTIN) + (size_t)7168 * 2048, 2048, 64, 28, e); })
  PHASE(6, { EpiKV e{(bf16_t*)(ws + OFF_K), (bf16_t*)(ws + OFF_V), 0, 0, 0};
             gemm_phase((const bf16_t*)(ws + OFF_CKVN), (const bf16_t*)(ws + OFF_WTKV), 512, 72, 16, e); })
  PHASE(7, kfin_phase(p))
  PHASE(8, attn_phase(p))
  PHASE(9, { EpiMerge e{(bf16_t*)(ws + OFF_MERGED), (const bf16_t*)p.out};
             gemm_phase((const bf16_t*)(ws + OFF_OMLA), (const bf16_t*)(ws + OFF_WTBRM), 2048, 64, 8, e, (const bf16_t*)(ws + OFF_ORWKV), (const bf16_t*)(ws + OFF_WTBRR)); })
  PHASE(10, { EpiOut e{p.in[I_XP], p.in[I_XS], mod, (bf16_t*)(ws + OFF_X1), {}};
              gemm_phase((const bf16_t*)(ws + OFF_MERGED), (const bf16_t*)(ws + OFF_WTOUT), 2048, 64, 8, e); })
  PHASE(11, { ffconv_phase(p); norm_mod_phase<true>((const float*)(ws + OFF_X1), nullptr, p.in[I_NORM2], mod, 3, 4, (bf16_t*)(ws + OFF_H2)); })
  PHASE(12, { EpiFF1 e{(bf16_t*)(ws + OFF_FF)};
              gemm_phase((const bf16_t*)(ws + OFF_H2), (const bf16_t*)(ws + OFF_WTFFIN), 2048, 64, 32, e); })
  PHASE(13, { EpiFF2 e{mod, p.out, (const bf16_t*)(ws + OFF_X1), {}};
              gemm_phase((const bf16_t*)(ws + OFF_FF), (const bf16_t*)(ws + OFF_WTFFOUT), 8192, 64, 8, e); })
}

extern "C" void kernel_launch(void* const* d_in, const int* in_sizes, int n_in, void* d_out, int out_size, void* d_ws, size_t ws_size, hipStream_t stream) {
  static int grid_blocks = 0;
  if (n_in != 32 || ws_size < WS_NEED) { fprintf(stderr, "kernel_launch: bad n_in %d or ws_size %zu (need %zu)\n", n_in, ws_size, (size_t)WS_NEED); return; }
  if (!grid_blocks) {
    int dev = 0, cus = 0, per_cu = 0;
    hipGetDevice(&dev);
    hipDeviceGetAttribute(&cus, hipDeviceAttributeMultiprocessorCount, dev);
    hipFuncSetAttribute((const void*)fwd_megakernel, hipFuncAttributeMaxDynamicSharedMemorySize, SHM_BYTES);
    hipOccupancyMaxActiveBlocksPerMultiprocessor(&per_cu, fwd_megakernel, 512, SHM_BYTES);
    if (per_cu < 1) per_cu = 1;
    grid_blocks = cus * 1;
    if (grid_blocks > 256) grid_blocks = 256;
    grid_blocks &= ~7;
  }
  Params p{};
  for (int i = 0; i < 32; ++i) p.in[i] = (const float*)d_in[i];
  p.out = (float*)d_out; p.ws = (char*)d_ws;
#ifdef PROBE_PHASES
  { const int probe[] = {PROBE_PHASES}; int cur = 0;
    auto launch = [&](int l2, int h2) { void* a2[] = {&p, &l2, &h2}; hipMemsetAsync((char*)d_ws + OFF_XBAR, 0, XCD_BAR_WORDS * 4, stream);
      hipError_t e = hipLaunchCooperativeKernel((void*)fwd_megakernel, dim3(grid_blocks), dim3(512), a2, SHM_BYTES, stream);
      if (e != hipSuccess) fprintf(stderr, "cooperative launch failed: %s (grid %d)\n", hipGetErrorString(e), grid_blocks); };
    for (unsigned i = 0; i < sizeof(probe) / sizeof(int); ++i) { launch(cur, probe[i] + 1); launch(probe[i], probe[i] + 1); cur = probe[i] + 1; }
    if (cur < 14) launch(cur, 14); }
#else
  int lo = 0, hi = 14;
  void* args[] = {&p, &lo, &hi};
  hipMemsetAsync((char*)d_ws + OFF_XBAR, 0, XCD_BAR_WORDS * 4, stream);
  hipError_t e = hipLaunchCooperativeKernel((void*)fwd_megakernel, dim3(grid_blocks), dim3(512), args, SHM_BYTES, stream);
  if (e != hipSuccess) fprintf(stderr, "cooperative launch failed: %s (grid %d)\n", hipGetErrorString(e), grid_blocks);
#endif
}
```

```cpp
#include <hip/hip_runtime.h>
#include <hip/hip_cooperative_groups.h>
#include <cstdio>
namespace cg = cooperative_groups;

typedef unsigned short bf16_t;
typedef short bf16x8 __attribute__((ext_vector_type(8)));
typedef short s16x4 __attribute__((ext_vector_type(4)));
typedef float f32x4 __attribute__((ext_vector_type(4)));
typedef float f32x16 __attribute__((ext_vector_type(16)));
typedef unsigned u32x4 __attribute__((ext_vector_type(4)));
typedef unsigned u32x2 __attribute__((ext_vector_type(2)));

constexpr int NT = 16384, NPR = 8192;
constexpr size_t MiB = 1ull << 20;
constexpr size_t OFF_ZRKV = 0, OFF_H = 192 * MiB, OFF_WTIN = 256 * MiB, OFF_WTKV = 312 * MiB, OFF_ZCKV = 316 * MiB, OFF_MISC = 348 * MiB,
                 OFF_CKVN = 380 * MiB, OFF_BON = 494 * MiB, OFF_MOD = 402 * MiB, OFF_ROPE = 403 * MiB, OFF_XBAR = 404 * MiB, OFF_ORWKV = 406 * MiB,
                 OFF_WTBRM = 470 * MiB, OFF_WTBRR = 478 * MiB, OFF_WTOUT = 486 * MiB, WS_NEED = 510 * MiB;
constexpr size_t OFF_ZQ = 0, OFF_V = 96 * MiB, OFF_K = 192 * MiB, OFF_OMLA = 316 * MiB, OFF_MERGED = 0, OFF_H2 = 256 * MiB,
                 OFF_WTFFIN = 320 * MiB, OFF_WTFFOUT = 352 * MiB, OFF_FF = 0, OFF_X1 = 406 * MiB;
constexpr size_t OUT_CKV = 33554432, OUT_KR = 37748736, OUT_ST = 38273024;
constexpr int SHM_BYTES = 131072;

struct Params { const float* in[32]; float* out; char* ws; };
enum { I_XP = 0, I_XS, I_CCKV, I_CKR, I_STATE, I_C, I_CCTX, I_NORM1, I_WADA, I_BADA, I_WIN, I_QNORM, I_KVNORM, I_WKVUP, I_KNORM, I_CONV,
       I_KK, I_KA, I_RK, I_W0, I_WUP, I_A0, I_AUP, I_GUP, I_LNXW, I_LNXB, I_WBRM, I_WBRR, I_WOUT, I_NORM2, I_WFFIN, I_WFFOUT };

extern __shared__ __attribute__((aligned(16))) char smem[];

typedef float f32x2_ __attribute__((ext_vector_type(2)));
typedef __bf16 bf16x2_ __attribute__((ext_vector_type(2)));
__device__ __forceinline__ unsigned cvtpk(float lo, float hi) { f32x2_ v = {lo, hi}; bf16x2_ b = __builtin_convertvector(v, bf16x2_); return *reinterpret_cast<unsigned*>(&b); }
__device__ __forceinline__ float bf2f(bf16_t b) { return __uint_as_float(((unsigned)b) << 16); }
__device__ __forceinline__ bf16_t f2bf(float x) { return (bf16_t)(cvtpk(x, 0.f) & 0xffffu); }
#define DPPF(x, ctrl) __int_as_float(__builtin_amdgcn_update_dpp(0, __float_as_int(x), (ctrl), 0xf, 0xf, false))
__device__ __forceinline__ float rowsum16(float v) { v += DPPF(v, 0xB1); v += DPPF(v, 0x4E); v += DPPF(v, 0x141); v += DPPF(v, 0x140); return v; }
__device__ __forceinline__ float wsum(float v) {
  v = rowsum16(v);
  const int iv = __float_as_int(v);
  return __int_as_float(__builtin_amdgcn_readlane(iv, 0)) + __int_as_float(__builtin_amdgcn_readlane(iv, 16)) + __int_as_float(__builtin_amdgcn_readlane(iv, 32)) + __int_as_float(__builtin_amdgcn_readlane(iv, 48));
}
__device__ __forceinline__ float fexp(float x) { return __builtin_amdgcn_exp2f(x * 1.4426950408889634f); }
__device__ __forceinline__ float sigmoidf_(float x) { return __builtin_amdgcn_rcpf(1.f + fexp(-x)); }
__device__ __forceinline__ int otid() { int t = threadIdx.x; asm volatile("" : "+v"(t)); return t; }
__device__ __forceinline__ int cond_of(int row) { return row < NPR ? 0 : 1 + ((row - NPR) >> 10); }
__device__ __forceinline__ int xcd_bid() { const int G = gridDim.x, b = blockIdx.x; return (G % 8 == 0) ? (b % 8) * (G / 8) + b / 8 : b; }

constexpr int BM = 256, BK = 64, HALF = 128, HT = HALF * BK;
__device__ __forceinline__ int lds_byte(int r, int c) {
  int st = (r >> 4) * 2 + (c >> 5), rr = r & 15, cc = c & 31, ob = rr * 64 + cc * 2;
  return st * 1024 + (ob ^ (((ob >> 9) & 1) << 5));
}
__device__ __forceinline__ void stage_rc(int b, int& R, int& C) {
  int st = b / 1024, sb = b % 1024, swz = sb ^ (((sb >> 9) & 1) << 5);
  R = (st >> 1) * 16 + swz / 64; C = (st & 1) * 32 + (swz % 64) / 2;
}

#define LAS __attribute__((address_space(3)))
constexpr int HTB = HALF * BK * 2;
struct Unit { int pm, pn; };
struct Order {
  int total, nig, G, b0;
  __device__ __forceinline__ void init(int nM, int nN) { total = nM * nN; nig = 8 * nN; G = gridDim.x; b0 = xcd_bid(); }
  __device__ __forceinline__ bool next(int i, Unit& u) const { const int id = i * G + b0; if (id >= total) return false;
    const int gid = id / nig, w = id % nig; u.pm = gid * 8 + (w & 7); u.pn = w >> 3; return true; }
};
template <class Epi>
__device__ __forceinline__ void gemm_phase(const bf16_t* __restrict__ gA, const bf16_t* __restrict__ gBt, const int K, const int nM, const int nN, Epi& E,
                                           const bf16_t* __restrict__ gA2 = nullptr, const bf16_t* __restrict__ gBt2 = nullptr) {
  constexpr bool DUAL = Epi::DUAL;
  LAS unsigned char* lds = (LAS unsigned char*)smem;
  const int tid = otid(), wid = __builtin_amdgcn_readfirstlane(tid >> 6), lane = tid & 63, wr = wid >> 2, wc = wid & 3, fr = lane & 15, fq = lane >> 4;
  const int nt = K / BK;
  Order S; S.init(nM, nN);
  unsigned voffA[2];
#pragma unroll
  for (int i = 0; i < 2; ++i) { int R, C; stage_rc(tid * 16 + i * 8192, R, C); voffA[i] = (unsigned)(R * K + C) * 2u; }
  const size_t kstep = (size_t)(BK * 2), hstep = (size_t)HALF * K * 2, tstep = 2 * hstep;
  const unsigned ldsw = (unsigned)wid * 1024u;
  const int aoff = lds_byte(wr * 64 + fr, fq * 8), boff = lds_byte(wc * 32 + fr, fq * 8);
#define PG8_SA(b, h) (((b) * 2 + (h)) * HTB)
#define PG8_SB(b, h) ((4 + (b) * 2 + (h)) * HTB)
#define PG8_STAGE(bufoff, gbase) do { _Pragma("unroll") for (int _i = 0; _i < 2; ++_i) \
    __builtin_amdgcn_global_load_lds((const unsigned*)((const char*)(gbase) + voffA[_i]), (LAS unsigned*)(lds + (bufoff) + ldsw + _i * 8192), 16, 0, 0); } while (0)
#define PG8_LDA(dst, b, h) do { _Pragma("unroll") for (int m = 0; m < 4; ++m) _Pragma("unroll") for (int k = 0; k < 2; ++k) dst[m][k] = *(const LAS bf16x8*)(lds + PG8_SA(b, h) + aoff + m * 2048 + k * 1024); } while (0)
#define PG8_LDB(dst, b, h) do { _Pragma("unroll") for (int n = 0; n < 2; ++n) _Pragma("unroll") for (int k = 0; k < 2; ++k) dst[n][k] = *(const LAS bf16x8*)(lds + PG8_SB(b, h) + boff + n * 2048 + k * 1024); } while (0)
#define PG8_MMA(ai, bj, At, Bt) do { __builtin_amdgcn_s_setprio(1); _Pragma("unroll") for (int m = 0; m < 4; ++m) _Pragma("unroll") for (int n = 0; n < 2; ++n) _Pragma("unroll") for (int k = 0; k < 2; ++k) \
    acc[ai][bj][m][n] = __builtin_amdgcn_mfma_f32_16x16x32_bf16(Bt[n][k], At[m][k], acc[ai][bj][m][n], 0, 0, 0); __builtin_amdgcn_s_setprio(0); } while (0)
#define PG8_WAIT_V(n) asm volatile("s_waitcnt vmcnt(" #n ")" ::: "memory")
#define PG8_WAIT_L(n) asm volatile("s_waitcnt lgkmcnt(" #n ")" ::: "memory")
#define PG8_BAR __builtin_amdgcn_s_barrier()
#define PG8_SCHED __builtin_amdgcn_sched_barrier(0)
  Unit cur, nxt; int ui = 0, csub = 0, nsub = 0;
  __syncthreads();
  if (!S.next(0, cur)) return;
  f32x4 acc[2][2][4][2];
#pragma unroll
  for (int a = 0; a < 2; ++a)
#pragma unroll
    for (int b = 0; b < 2; ++b)
#pragma unroll
      for (int m = 0; m < 4; ++m)
#pragma unroll
        for (int n = 0; n < 2; ++n) acc[a][b][m][n] = (f32x4){0.f, 0.f, 0.f, 0.f};
  bf16x8 At[4][2], B0[2][2], B1[2][2];
  const char* cA = (const char*)gA + (size_t)cur.pm * tstep; const char* cB = (const char*)gBt + (size_t)cur.pn * tstep;
  PG8_STAGE(PG8_SB(0, 0), cB); PG8_STAGE(PG8_SA(0, 0), cA); PG8_STAGE(PG8_SB(0, 1), cB + hstep); PG8_STAGE(PG8_SA(0, 1), cA + hstep);
  if (wr == 1) PG8_BAR;
  PG8_WAIT_V(4); PG8_BAR;
  PG8_STAGE(PG8_SB(1, 0), cB + kstep); PG8_STAGE(PG8_SA(1, 0), cA + kstep); PG8_STAGE(PG8_SB(1, 1), cB + hstep + kstep);
  PG8_WAIT_V(6); PG8_BAR;
  for (;;) {
    bool has_next;
    if constexpr (DUAL) { nsub = (ui + 1) & 1; has_next = S.next((ui + 1) >> 1, nxt); } else has_next = S.next(ui + 1, nxt);
    const char* nAb = (const char*)((DUAL && nsub) ? gA2 : gA); const char* nBb = (const char*)((DUAL && nsub) ? gBt2 : gBt);
    const char* nA = has_next ? nAb + (size_t)nxt.pm * tstep : cA; const char* nB = has_next ? nBb + (size_t)nxt.pn * tstep : cB;
    for (int t = 0; t < nt; t += 2) {
      const bool last = (t == nt - 2);
      const char* a1 = cA + (size_t)(t + 1) * kstep;
      const char* a2 = last ? nA : cA + (size_t)(t + 2) * kstep; const char* b2 = last ? nB : cB + (size_t)(t + 2) * kstep;
      const char* a3 = a2 + kstep; const char* b3 = b2 + kstep;
      PG8_LDB(B0, 0, 0); PG8_SCHED; PG8_LDA(At, 0, 0); PG8_STAGE(PG8_SA(1, 1), a1 + hstep);
      PG8_WAIT_L(8); PG8_BAR; PG8_WAIT_L(0); PG8_MMA(0, 0, At, B0); PG8_BAR; PG8_SCHED;
      PG8_LDB(B1, 0, 1); PG8_STAGE(PG8_SB(0, 0), b2);
      PG8_BAR; PG8_WAIT_L(0); PG8_MMA(0, 1, At, B1); PG8_BAR;
      PG8_LDA(At, 0, 1); PG8_STAGE(PG8_SA(0, 0), a2);
      PG8_BAR; PG8_WAIT_L(0); PG8_MMA(1, 0, At, B0); PG8_BAR; PG8_SCHED;
      PG8_STAGE(PG8_SB(0, 1), b2 + hstep);
      PG8_WAIT_V(6); PG8_BAR; PG8_MMA(1, 1, At, B1); PG8_BAR;
      PG8_LDB(B0, 1, 0); PG8_SCHED; PG8_LDA(At, 1, 0); PG8_STAGE(PG8_SA(0, 1), a2 + hstep);
      PG8_WAIT_L(8); PG8_BAR; PG8_WAIT_L(0); PG8_MMA(0, 0, At, B0); PG8_BAR; PG8_SCHED;
      PG8_LDB(B1, 1, 1); PG8_STAGE(PG8_SB(1, 0), b3);
      PG8_BAR; PG8_WAIT_L(0); PG8_MMA(0, 1, At, B1); PG8_BAR;
      PG8_LDA(At, 1, 1); PG8_STAGE(PG8_SA(1, 0), a3);
      PG8_BAR; PG8_WAIT_L(0); PG8_MMA(1, 0, At, B0); PG8_BAR; PG8_SCHED;
      PG8_STAGE(PG8_SB(1, 1), b3 + hstep);
      PG8_WAIT_V(6); PG8_BAR; PG8_MMA(1, 1, At, B1); PG8_BAR;
    }
    const bool midpoint = DUAL && csub == 0;
    if constexpr (DUAL) { if (midpoint) { const int row0 = cur.pm * BM + wr * 64 + fr, col0 = cur.pn * BM + wc * 32 + fq * 8;
#pragma unroll
      for (int ai = 0; ai < 2; ++ai) {
        typename Epi::Aux aux[8];
#pragma unroll
        for (int m = 0; m < 4; ++m)
#pragma unroll
          for (int bj = 0; bj < 2; ++bj) E.loadmid(row0 + ai * HALF + m * 16, col0 + bj * HALF, aux[m * 2 + bj]);
        __builtin_amdgcn_sched_barrier(0);
#pragma unroll
        for (int m = 0; m < 4; ++m)
#pragma unroll
          for (int bj = 0; bj < 2; ++bj) E.applymid(acc[ai][bj][m][0], acc[ai][bj][m][1], aux[m * 2 + bj]);
        __builtin_amdgcn_sched_barrier(0); } } }
    if (!midpoint) {
    const int row0 = cur.pm * BM + wr * 64 + fr, col0 = cur.pn * BM + wc * 32 + fq * 8;
    E.tile(cur.pm, cur.pn, col0);
    if constexpr (Epi::PRELOAD) {
#pragma unroll
      for (int ai = 0; ai < 2; ++ai) {
        typename Epi::Aux aux[8];
#pragma unroll
        for (int m = 0; m < 4; ++m)
#pragma unroll
          for (int bj = 0; bj < 2; ++bj) E.load(row0 + ai * HALF + m * 16, col0 + bj * HALF, aux[m * 2 + bj]);
        __builtin_amdgcn_sched_barrier(0);
#pragma unroll
        for (int m = 0; m < 4; ++m)
#pragma unroll
          for (int bj = 0; bj < 2; ++bj) E.apply(row0 + ai * HALF + m * 16, col0 + bj * HALF, bj, acc[ai][bj][m][0], acc[ai][bj][m][1], aux[m * 2 + bj]);
        __builtin_amdgcn_sched_barrier(0); }
    } else {
#pragma unroll
      for (int ai = 0; ai < 2; ++ai)
#pragma unroll
        for (int m = 0; m < 4; ++m)
#pragma unroll
          for (int bj = 0; bj < 2; ++bj) E(row0 + ai * HALF + m * 16, col0 + bj * HALF, acc[ai][bj][m][0], acc[ai][bj][m][1]); } }
    if (!has_next) break;
    if (!midpoint) {
#pragma unroll
    for (int a = 0; a < 2; ++a)
#pragma unroll
      for (int b = 0; b < 2; ++b)
#pragma unroll
        for (int m = 0; m < 4; ++m)
#pragma unroll
          for (int n = 0; n < 2; ++n) acc[a][b][m][n] = (f32x4){0.f, 0.f, 0.f, 0.f}; }
    cur = nxt; cA = nA; cB = nB; csub = nsub; ++ui;
  }
  PG8_WAIT_V(0);
  if (wr == 0) PG8_BAR;
  PG8_BAR;
#undef PG8_SA
#undef PG8_SB
#undef PG8_STAGE
#undef PG8_LDA
#undef PG8_LDB
#undef PG8_MMA
}

__device__ __forceinline__ u32x2 pack4(f32x4 v) { u32x2 r; r[0] = cvtpk(v[0], v[1]); r[1] = cvtpk(v[2], v[3]); return r; }
__device__ __forceinline__ u32x4 pack8v(f32x4 a, f32x4 b) { u32x4 r = {cvtpk(a[0], a[1]), cvtpk(a[2], a[3]), cvtpk(b[0], b[1]), cvtpk(b[2], b[3])}; return r; }
__device__ __forceinline__ f32x4 unpack4(u32x2 u) { f32x4 v; v[0] = __uint_as_float(u[0] << 16); v[1] = __uint_as_float(u[0] & 0xffff0000u); v[2] = __uint_as_float(u[1] << 16); v[3] = __uint_as_float(u[1] & 0xffff0000u); return v; }

struct EpiIn1 {
  static constexpr bool DUAL = false, PRELOAD = false;
  bf16_t* zrkv; float* zckv; float* misc; float* out;
  __device__ __forceinline__ void tile(int, int, int) {}
  __device__ __forceinline__ void operator()(int row, int col, f32x4 v, f32x4 w) const {
    if (col < 6144) { *(u32x4*)(zrkv + (size_t)row * 6144 + col) = pack8v(v, w); }
    else if (col < 6656) { const int c = col - 6144; float* zp = zckv + (size_t)row * 512 + c; *(f32x4*)zp = v; *(f32x4*)(zp + 4) = w;
      if (row < NPR) { float* op = out + OUT_CKV + (size_t)row * 512 + c; *(f32x4*)op = v; *(f32x4*)(op + 4) = w; } }
    else { const int c = col - 6656; float* mp = misc + (size_t)row * 512 + c; *(f32x4*)mp = v; *(f32x4*)(mp + 4) = w;
      if (row < NPR && c < 64) { float* op = out + OUT_KR + (size_t)row * 64 + c; *(f32x4*)op = v; *(f32x4*)(op + 4) = w; } }
  }
};
struct EpiIn2 {
  static constexpr bool DUAL = false, PRELOAD = false;
  bf16_t* zq; bf16_t* gate;
  __device__ __forceinline__ void tile(int, int, int) {}
  __device__ __forceinline__ void operator()(int row, int col, f32x4 v, f32x4 w) const {
    if (col < 3072) { *(u32x4*)(zq + (size_t)row * 3072 + col) = pack8v(v, w); }
    else { f32x4 s, t; for (int i = 0; i < 4; ++i) { s[i] = sigmoidf_(v[i]); t[i] = sigmoidf_(w[i]); } *(u32x4*)(gate + (size_t)row * 4096 + (col - 3072)) = pack8v(s, t); }
  }
};
struct EpiKV {
  static constexpr bool DUAL = false, PRELOAD = false;
  bf16_t* Kb; bf16_t* Vb; size_t krow0; int brow, bcol;
  __device__ __forceinline__ void tile(int pm, int pn, int) {
    const int h = pn;
    if (pm < 32) krow0 = (size_t)(pm * 16 + h) * 256;
    else if (pm < 64) { const int q = pm - 32; krow0 = 131072 + (size_t)((q >> 2) * 16 + h) * 1280 + (q & 3) * 256; }
    else krow0 = 131072 + (size_t)((pm - 64) * 16 + h) * 1280 + 1024;
    brow = pm * 256; bcol = pn * 256;
  }
  __device__ __forceinline__ void operator()(int row, int col, f32x4 v, f32x4 w) const {
    const int rl = row - brow, c = col - bcol;
    if (c < 128) *(u32x4*)(Kb + (krow0 + rl) * 192 + c) = pack8v(v, w);
    else *(u32x4*)(Vb + (krow0 + rl) * 128 + (c - 128)) = pack8v(v, w);
  }
};
struct Aux8 { u32x4 a, b; };
struct AuxF8 { f32x4 a, b; };
__device__ __forceinline__ void unpack8(u32x4 u, f32x4& lo, f32x4& hi) { lo = unpack4((u32x2){u[0], u[1]}); hi = unpack4((u32x2){u[2], u[3]}); }
struct EpiMerge {
  static constexpr bool DUAL = true, PRELOAD = true;
  typedef Aux8 Aux;
  bf16_t* merged; const bf16_t* gate;
  __device__ __forceinline__ void tile(int, int, int) {}
  __device__ __forceinline__ void loadmid(int row, int col, Aux& x) const {
    x.a = *(const u32x4*)(gate + (size_t)row * 4096 + col); x.b = *(const u32x4*)(gate + (size_t)row * 4096 + 2048 + col);
  }
  __device__ __forceinline__ void applymid(f32x4& v, f32x4& w, const Aux& x) const {
    f32x4 ga0, ga1, gb0, gb1; unpack8(x.a, ga0, ga1); unpack8(x.b, gb0, gb1);
#pragma unroll
    for (int i = 0; i < 4; ++i) { v[i] = v[i] * ga0[i] * __builtin_amdgcn_rcpf(gb0[i]); w[i] = w[i] * ga1[i] * __builtin_amdgcn_rcpf(gb1[i]); }
  }
  __device__ __forceinline__ void load(int row, int col, Aux& x) const { x.b = *(const u32x4*)(gate + (size_t)row * 4096 + 2048 + col); x.a = x.b; }
  __device__ __forceinline__ void apply(int row, int col, int, f32x4 v, f32x4 w, const Aux& x) const {
    f32x4 gb0, gb1; unpack8(x.b, gb0, gb1);
    *(u32x4*)(merged + (size_t)row * 2048 + col) = pack8v(gb0 * v, gb1 * w);
  }
};
struct EpiOut {
  static constexpr bool DUAL = false, PRELOAD = true;
  typedef AuxF8 Aux;
  const float* xp; const float* xs; const float* mod; bf16_t* X1; f32x4 g[2][2];
  __device__ __forceinline__ void tile(int pm, int, int col0) {
    const float* mg = mod + cond_of(pm * BM) * 12288 + 2 * 2048 + col0;
#pragma unroll
    for (int bj = 0; bj < 2; ++bj)
#pragma unroll
      for (int n = 0; n < 2; ++n) g[bj][n] = *(const f32x4*)(mg + bj * HALF + n * 4);
  }
  __device__ __forceinline__ void load(int row, int col, Aux& x) const {
    const float* xr = (row < NPR ? xp + (size_t)row * 2048 : xs + (size_t)(row - NPR) * 2048) + col; x.a = *(const f32x4*)xr; x.b = *(const f32x4*)(xr + 4);
  }
  __device__ __forceinline__ void apply(int row, int col, int bj, f32x4 v, f32x4 w, const Aux& x) const {
    *(u32x4*)(X1 + (size_t)row * 2048 + col) = pack8v(x.a + g[bj][0] * v, x.b + g[bj][1] * w);
  }
};
struct EpiFF1 {
  static constexpr bool DUAL = false, PRELOAD = false;
  bf16_t* ff;
  __device__ __forceinline__ void tile(int, int, int) {}
  __device__ __forceinline__ void operator()(int row, int col, f32x4 v, f32x4 w) const {
    f32x4 s, t; for (int i = 0; i < 4; ++i) { const float r = fmaxf(v[i], 0.f); s[i] = r * r; const float q = fmaxf(w[i], 0.f); t[i] = q * q; }
    *(u32x4*)(ff + (size_t)row * 8192 + col) = pack8v(s, t);
  }
};
struct EpiFF2 {
  static constexpr bool DUAL = false, PRELOAD = true;
  typedef u32x4 Aux;
  const float* mod; float* Y; const bf16_t* X1; f32x4 g[2][2];
  __device__ __forceinline__ void tile(int pm, int, int col0) {
    const float* mg = mod + cond_of(pm * BM) * 12288 + 5 * 2048 + col0;
#pragma unroll
    for (int bj = 0; bj < 2; ++bj)
#pragma unroll
      for (int n = 0; n < 2; ++n) g[bj][n] = *(const f32x4*)(mg + bj * HALF + n * 4);
  }
  __device__ __forceinline__ void load(int row, int col, Aux& x) const { x = *(const u32x4*)(X1 + (size_t)row * 2048 + col); }
  __device__ __forceinline__ void apply(int row, int col, int bj, f32x4 v, f32x4 w, const Aux& x) const {
    f32x4 a, b; unpack8(x, a, b);
    float* yp = Y + (size_t)row * 2048 + col; *(f32x4*)yp = a + g[bj][0] * v; *(f32x4*)(yp + 4) = b + g[bj][1] * w;
  }
};

__device__ __forceinline__ void convT_tile(const float* __restrict__ src, int Nsrc, int K, int k0, int srcn0, bf16_t* __restrict__ dst, int dstn0) {
  float* tile = (float*)smem;
  const int tid = otid();
  __syncthreads();
#pragma unroll
  for (int i = 0; i < 8; ++i) { const int idx = tid + i * 512, r = idx >> 6, c = idx & 63;
    tile[r * 65 + c] = srcn0 >= 0 ? src[(size_t)(k0 + r) * Nsrc + srcn0 + c] : 0.f; }
  __syncthreads();
  const int n = tid >> 3, ks = tid & 7;
  float v[8];
#pragma unroll
  for (int e = 0; e < 8; ++e) v[e] = tile[(ks * 8 + e) * 65 + n];
  u32x4 o = {cvtpk(v[0], v[1]), cvtpk(v[2], v[3]), cvtpk(v[4], v[5]), cvtpk(v[6], v[7])};
  *(u32x4*)(dst + (size_t)(dstn0 + n) * K + k0 + ks * 8) = o;
}
__device__ __forceinline__ int win_src_col(int nb) {
  if (nb < 96) return 3648 + (nb % 3) * 2048 + (nb / 3) * 64;
  if (nb < 104) return 3072 + (nb - 96) * 64;
  if (nb == 104) return 3584;
  if (nb < 111) return 9792 + (nb - 105) * 64;
  if (nb == 111) return -1;
  if (nb < 160) return (nb - 112) * 64;
  return 10176 + (nb - 160) * 64;
}

template <class F>
__device__ __forceinline__ void convT_tile4(const float* __restrict__ src, int Nsrc, int K, int k0, F srccol, bf16_t* __restrict__ dst, int dstn0) {
  float* tile = (float*)smem;
  const int tid = otid();
  __syncthreads();
  f32x4 v[8];
#pragma unroll
  for (int i = 0; i < 8; ++i) { const int idx = tid + i * 512, r = idx >> 6, c4 = idx & 63; const int sc = srccol(c4 >> 4);
    v[i] = sc >= 0 ? *(const f32x4*)(src + (size_t)(k0 + r) * Nsrc + sc + (c4 & 15) * 4) : (f32x4){0.f, 0.f, 0.f, 0.f}; }
#pragma unroll
  for (int i = 0; i < 8; ++i) { const int idx = tid + i * 512, r = idx >> 6, c4 = idx & 63; *(f32x4*)(tile + r * 260 + c4 * 4) = v[i]; }
  __syncthreads();
  const int n = tid >> 1, kh = tid & 1;
  bf16_t* dp = dst + (size_t)(dstn0 + n) * K + k0 + kh * 32;
#pragma unroll
  for (int q = 0; q < 4; ++q) { float x[8];
#pragma unroll
    for (int e = 0; e < 8; ++e) x[e] = tile[(kh * 32 + q * 8 + e) * 260 + n];
    u32x4 o = {cvtpk(x[0], x[1]), cvtpk(x[2], x[3]), cvtpk(x[4], x[5]), cvtpk(x[6], x[7])};
    *(u32x4*)(dp + q * 8) = o; }
}

struct CJob { const float* src; bf16_t* dst; int Nsrc, K, k0, sc, dstn0; };
template <class D>
__device__ __forceinline__ void conv_loop(D decode, const int njobs) {
  float* tile = (float*)smem;
  const int tid = otid(), c4 = tid & 63, r0 = tid >> 6, sb = c4 >> 4, n = tid >> 1, kh = tid & 1, G = gridDim.x;
  const int rho = n & 31, ii = rho & 15, nsrc = (n & ~31) + 8 * (ii >> 2) + 4 * (rho >> 4) + (ii & 3);
  int j = blockIdx.x;
  if (j >= njobs) return;
  CJob cur = decode(j, sb);
  f32x4 v[8];
#define CLOAD(J) do { _Pragma("unroll") for (int i = 0; i < 8; ++i) \
    v[i] = (J).sc >= 0 ? *(const f32x4*)((J).src + (size_t)((J).k0 + r0 + i * 8) * (J).Nsrc + (J).sc + (c4 & 15) * 4) : (f32x4){0.f, 0.f, 0.f, 0.f}; } while (0)
  CLOAD(cur);
  for (;;) {
    __syncthreads();
#pragma unroll
    for (int i = 0; i < 8; ++i) *(f32x4*)(tile + (r0 + i * 8) * 260 + c4 * 4) = v[i];
    __syncthreads();
    const int jn = j + G; const bool more = jn < njobs;
    CJob nxt = cur;
    if (more) { nxt = decode(jn, sb); CLOAD(nxt); }
    bf16_t* dp = cur.dst + (size_t)(cur.dstn0 + n) * cur.K + cur.k0 + kh * 32;
#pragma unroll
    for (int q = 0; q < 4; ++q) { float x[8];
#pragma unroll
      for (int e = 0; e < 8; ++e) x[e] = tile[(kh * 32 + q * 8 + e) * 260 + nsrc];
      u32x4 o = {cvtpk(x[0], x[1]), cvtpk(x[2], x[3]), cvtpk(x[4], x[5]), cvtpk(x[6], x[7])};
      *(u32x4*)(dp + q * 8) = o; }
    if (!more) break;
    cur = nxt; j = jn;
  }
#undef CLOAD
}

__device__ __forceinline__ void phase0(const Params& p) {
  const int tid = otid(), wid = tid >> 6, lane = tid & 63, G = gridDim.x;
  char* ws = p.ws;
  if (blockIdx.x == 0) {
    float* rope = (float*)(ws + OFF_ROPE);
    for (int i = tid; i < 1024; i += 512) { const int pos = i >> 4, pp = i & 15;
      const float inv = powf(10000.f, -(float)pp / 16.f); const float ang = (float)pos * inv;
      rope[i * 2] = cosf(ang); rope[i * 2 + 1] = sinf(ang); }
  }
  { const float* cckv = p.in[I_CCKV]; const float* kvn = p.in[I_KVNORM]; bf16_t* ckvn = (bf16_t*)(ws + OFF_CKVN);
    for (int r = blockIdx.x * 8 + wid; r < 2048; r += G * 8) {
      const float* xr = cckv + (size_t)r * 512 + lane * 8;
      f32x4 a = *(const f32x4*)xr, b = *(const f32x4*)(xr + 4);
      float ss = 0; for (int i = 0; i < 4; ++i) ss += a[i] * a[i] + b[i] * b[i];
      ss = wsum(ss); const float rs = rsqrtf(ss * (1.f / 512.f) + 1e-6f);
      const f32x4 g0 = *(const f32x4*)(kvn + lane * 8), g1 = *(const f32x4*)(kvn + lane * 8 + 4);
      a = a * rs * g0; b = b * rs * g1;
      u32x4 o = {cvtpk(a[0], a[1]), cvtpk(a[2], a[3]), cvtpk(b[0], b[1]), cvtpk(b[2], b[3])};
      *(u32x4*)(ckvn + (size_t)(NT + r) * 512 + lane * 8) = o;
    } }
  { float* sc = (float*)smem; float* mod = (float*)(ws + OFF_MOD);
    const float* wada = p.in[I_WADA];
    for (int cb = blockIdx.x; cb < 256; cb += G) {
      __syncthreads();
      for (int i = tid; i < 9 * 2048; i += 512) { const int g = i >> 11, k = i & 2047; const float c = g == 0 ? p.in[I_CCTX][k] : p.in[I_C][(g - 1) * 2048 + k]; sc[i] = c * sigmoidf_(c); }
      __syncthreads();
      const int c4 = tid % 12, r0 = tid / 12;
      f32x4 acc[9];
#pragma unroll
      for (int g = 0; g < 9; ++g) acc[g] = (f32x4){0.f, 0.f, 0.f, 0.f};
      if (r0 < 42) {
        const float* wp = wada + (size_t)cb * 48 + c4 * 4;
#pragma unroll 7
        for (int k = r0; k < 2048; k += 42) { const f32x4 w = *(const f32x4*)(wp + (size_t)k * 12288);
#pragma unroll
          for (int g = 0; g < 9; ++g) acc[g] += w * sc[g * 2048 + k]; }
      }
      __syncthreads();
      if (r0 < 42) {
#pragma unroll
        for (int g = 0; g < 9; ++g) *(f32x4*)(sc + (r0 * 9 + g) * 48 + c4 * 4) = acc[g];
      }
      __syncthreads();
      if (tid < 432) { const int g = tid / 48, c = tid % 48; float sum = 0.f;
        for (int r = 0; r < 42; ++r) sum += sc[(r * 9 + g) * 48 + c];
        mod[g * 12288 + cb * 48 + c] = sum + p.in[I_BADA][cb * 48 + c]; }
    } }
  conv_loop([&p, ws](int j, int sb) { CJob c;
    if (j < 1792) { const int nt4 = j >> 5, kb = j & 31; c.src = p.in[I_WIN]; c.dst = (bf16_t*)(ws + OFF_WTIN); c.Nsrc = 14272; c.K = 2048; c.k0 = kb * 64; c.sc = win_src_col(nt4 * 4 + sb); c.dstn0 = nt4 * 256; }
    else if (j < 1920) { const int jj = j - 1792, nt4 = jj >> 3, kb = jj & 7; c.src = p.in[I_WKVUP]; c.dst = (bf16_t*)(ws + OFF_WTKV); c.Nsrc = 4096; c.K = 512; c.k0 = kb * 64; c.sc = nt4 * 256 + sb * 64; c.dstn0 = nt4 * 256; }
    else { const int jj = j - 1920, m = jj >> 8, r = jj & 255, nt4 = r >> 5, kb = r & 31;
      c.src = m == 0 ? p.in[I_WBRM] : m == 1 ? p.in[I_WBRR] : p.in[I_WOUT];
      c.dst = (bf16_t*)(ws + (m == 0 ? OFF_WTBRM : m == 1 ? OFF_WTBRR : OFF_WTOUT));
      c.Nsrc = 2048; c.K = 2048; c.k0 = kb * 64; c.sc = nt4 * 256 + sb * 64; c.dstn0 = nt4 * 256; }
    return c; }, 2688);
}

template <bool SRC16>
__device__ __forceinline__ void norm_mod_phase(const float* xa, const float* xb  , const float* nw, const float* mod, int ish, int isc, bf16_t* dst) {
  const int tid = otid(), wid = tid >> 6, lane = tid & 63;
  const int stride = gridDim.x * 8;
  for (int t0 = blockIdx.x * 8 + wid; t0 < NT; t0 += 2 * stride) {
    f32x4 x[2][8]; float ss[2] = {0.f, 0.f};
#pragma unroll
    for (int u = 0; u < 2; ++u) { const int t = t0 + u * stride < NT ? t0 + u * stride : t0;
      if constexpr (SRC16) { const bf16_t* xr = (const bf16_t*)xa + (size_t)t * 2048;
#pragma unroll
        for (int i = 0; i < 8; ++i) x[u][i] = unpack4(*(const u32x2*)(xr + i * 256 + lane * 4)); }
      else { const float* xr = t < NPR ? xa + (size_t)t * 2048 : xb + (size_t)(t - NPR) * 2048;
#pragma unroll
        for (int i = 0; i < 8; ++i) x[u][i] = *(const f32x4*)(xr + i * 256 + lane * 4); } }
    __builtin_amdgcn_sched_barrier(0);
#pragma unroll
    for (int u = 0; u < 2; ++u) {
#pragma unroll
      for (int i = 0; i < 8; ++i) ss[u] += x[u][i][0] * x[u][i][0] + x[u][i][1] * x[u][i][1] + x[u][i][2] * x[u][i][2] + x[u][i][3] * x[u][i][3];
      ss[u] = wsum(ss[u]); }
#pragma unroll
    for (int u = 0; u < 2; ++u) { const int t = t0 + u * stride; if (t >= NT) break;
      const float* mg = mod + cond_of(t) * 12288; const float rs = rsqrtf(ss[u] * (1.f / 2048.f) + 1e-6f);
      f32x4 w[8], sv[8], sh[8];
#pragma unroll
      for (int i = 0; i < 8; ++i) { const int c = i * 256 + lane * 4; w[i] = *(const f32x4*)(nw + c); sv[i] = *(const f32x4*)(mg + isc * 2048 + c); sh[i] = *(const f32x4*)(mg + ish * 2048 + c); }
      __builtin_amdgcn_sched_barrier(0);
#pragma unroll
      for (int i = 0; i < 8; ++i) { const int c = i * 256 + lane * 4;
        const f32x4 h = x[u][i] * rs * w[i] * (1.f + sv[i]) + sh[i];
        *(u32x2*)(dst + (size_t)t * 2048 + c) = pack4(h); }
      __builtin_amdgcn_sched_barrier(0); }
  }
}

__device__ __forceinline__ float dpp_xor1(float x) { return __int_as_float(__builtin_amdgcn_update_dpp(0, __float_as_int(x), 0xB1, 0xf, 0xf, false)); }
__device__ __forceinline__ float dpp_xor2(float x) { return __int_as_float(__builtin_amdgcn_update_dpp(0, __float_as_int(x), 0x4E, 0xf, 0xf, false)); }

typedef float f32x2 __attribute__((ext_vector_type(2)));
__device__ __forceinline__ bf16x8 pack8(const float* x) { u32x4 w = {cvtpk(x[0], x[1]), cvtpk(x[2], x[3]), cvtpk(x[4], x[5]), cvtpk(x[6], x[7])}; return *reinterpret_cast<bf16x8*>(&w); }
__device__ __forceinline__ float tanh_(float x) { return 2.f * __builtin_amdgcn_rcpf(1.f + fexp(-2.f * x)) - 1.f; }

__device__ __forceinline__ void scan_phase(const Params& p) {
  int tid_ = threadIdx.x; asm volatile("" : "+v"(tid_));
  const int tid = tid_, wid = __builtin_amdgcn_readfirstlane(tid >> 6), lane = tid & 63, uw = wid & 3;
  float* lds = (float*)smem;
  float* resb = lds + 2 * 4 * 3072 + uw * 1024;
  const bf16_t* ZRKV = (const bf16_t*)(p.ws + OFF_ZRKV);
  const float* MISC = (const float*)(p.ws + OFF_MISC);
  float* BON = (float*)(p.ws + OFF_BON);
  bf16_t* YS = (bf16_t*)p.out;
  for (int item = blockIdx.x; item < 256; item += gridDim.x) {
    const bool samp = item < 128;
    const int T = samp ? 1024 : 256, rounds = samp ? 1 : 4, nch = T / 8;
    for (int rd = 0; rd < rounds; ++rd) {
      const int u = samp ? item * 4 + uw : (item - 128) * 16 + rd * 4 + uw;
      const int b = u >> 6, h = (u >> 1) & 31, d = u & 1, tb = samp ? NPR + b * 1024 : b * 256;
      if (wid >= 4) {
        const int hc = h * 64 + lane, fr = lane & 15, fq = lane >> 4;
        const float* cv = p.in[I_CONV];
        const float cr0 = cv[hc], cr1 = cv[6144 + hc], cr2 = cv[12288 + hc];
        const float ck0 = cv[2048 + hc], ck1 = cv[6144 + 2048 + hc], ck2 = cv[12288 + 2048 + hc];
        const float cv0 = cv[4096 + hc], cv1 = cv[6144 + 4096 + hc], cv2 = cv[12288 + 4096 + hc];
        const float kkw = p.in[I_KK][hc], kaw = p.in[I_KA][hc], rkw = p.in[I_RK][hc], w0c = p.in[I_W0][d * 2048 + hc], a0c = p.in[I_A0][d * 2048 + hc];
        bf16x8 bw[2][4], ba[2][4];
        { bf16_t* st16 = (bf16_t*)(lds + uw * 3072);
#pragma unroll 1
          for (int ps = 0; ps < 2; ++ps) {
            const float* src = (ps ? p.in[I_AUP] : p.in[I_WUP]) + (size_t)d * 64 * 2048 + hc;
#pragma unroll 8
            for (int j = 0; j < 64; ++j) st16[lane * 72 + j] = f2bf(src[(size_t)j * 2048]);
            asm volatile("s_waitcnt lgkmcnt(0)" ::: "memory"); __builtin_amdgcn_wave_barrier();
#pragma unroll
            for (int ks = 0; ks < 2; ++ks)
#pragma unroll
              for (int nt = 0; nt < 4; ++nt) { const bf16x8 f = *(const bf16x8*)(st16 + (nt * 16 + fr) * 72 + ks * 32 + fq * 8); if (ps) ba[ks][nt] = f; else bw[ks][nt] = f; }
            asm volatile("s_waitcnt lgkmcnt(0)" ::: "memory"); __builtin_amdgcn_wave_barrier();
          } }
        f32x4 mw[2][2], ma[2][2];
        float zr[10], zk[10], zv[10], nzr[10], nzk[10], nzv[10];
#define LOADM(c) do { const int plo_ = d ? T - 8 - (c) * 8 : (c) * 8; const float* mp_ = MISC + (size_t)(tb + plo_ + (fr & 7)) * 512 + d * 64 + fq * 8; \
          _Pragma("unroll") for (int ks = 0; ks < 2; ++ks) { mw[ks][0] = *(const f32x4*)(mp_ + 64 + ks * 32); mw[ks][1] = *(const f32x4*)(mp_ + 68 + ks * 32); \
            ma[ks][0] = *(const f32x4*)(mp_ + 192 + ks * 32); ma[ks][1] = *(const f32x4*)(mp_ + 196 + ks * 32); } } while (0)
#define LOADZ(c, R, Kk, V) do { const int plo_ = d ? T - 8 - (c) * 8 : (c) * 8; \
          _Pragma("unroll") for (int rr = 0; rr < 10; ++rr) { const int pos_ = plo_ - 1 + rr; const bool ok_ = pos_ >= 0 && pos_ < T; const int pc_ = ok_ ? pos_ : plo_; \
            const bf16_t* zc_ = ZRKV + (size_t)(tb + pc_) * 6144 + h * 192 + lane; const float a_ = bf2f(zc_[0]), b_ = bf2f(zc_[64]), c_ = bf2f(zc_[128]); \
            R[rr] = ok_ ? a_ : 0.f; Kk[rr] = ok_ ? b_ : 0.f; V[rr] = ok_ ? c_ : 0.f; } } while (0)
#define LORA() do { bf16x8 aw[2], aa[2]; \
          _Pragma("unroll") for (int ks = 0; ks < 2; ++ks) { float x[8], y[8]; \
            _Pragma("unroll") for (int e = 0; e < 4; ++e) { x[e] = tanh_(mw[ks][0][e]); x[4 + e] = tanh_(mw[ks][1][e]); y[e] = ma[ks][0][e]; y[4 + e] = ma[ks][1][e]; } \
            aw[ks] = pack8(x); aa[ks] = pack8(y); } \
          _Pragma("unroll") for (int nt = 0; nt < 4; ++nt) { f32x4 cw = {0.f, 0.f, 0.f, 0.f}, ca = {0.f, 0.f, 0.f, 0.f}; \
            cw = __builtin_amdgcn_mfma_f32_16x16x32_bf16(aw[0], bw[0][nt], cw, 0, 0, 0); cw = __builtin_amdgcn_mfma_f32_16x16x32_bf16(aw[1], bw[1][nt], cw, 0, 0, 0); \
            ca = __builtin_amdgcn_mfma_f32_16x16x32_bf16(aa[0], ba[0][nt], ca, 0, 0, 0); ca = __builtin_amdgcn_mfma_f32_16x16x32_bf16(aa[1], ba[1][nt], ca, 0, 0, 0); \
            if (fq < 2) { _Pragma("unroll") for (int e = 0; e < 4; ++e) { resb[(fq * 4 + e) * 128 + nt * 16 + fr] = cw[e]; resb[(fq * 4 + e) * 128 + 64 + nt * 16 + fr] = ca[e]; } } } \
          asm volatile("s_waitcnt lgkmcnt(0)" ::: "memory"); __builtin_amdgcn_wave_barrier(); } while (0)
        LOADM(0); LOADZ(0, zr, zk, zv); LORA();
        for (int it = 0; it <= nch; ++it) {
          if (it < nch) {
            float* buf = lds + ((it & 1) * 4 + uw) * 3072;
            const int plo = d ? T - 8 - it * 8 : it * 8;
            const int cn = it + 1 < nch ? it + 1 : it;
            LOADM(cn); LOADZ(cn, nzr, nzk, nzv);
            float uA[8], kkA[8], kkaA[8], kdA[8], rA[8];
#pragma unroll
            for (int pi = 0; pi < 8; ++pi) {
              const size_t t = tb + plo + pi;
              const float r = zr[pi] * cr0 + zr[pi + 1] * cr1 + zr[pi + 2] * cr2, k = zk[pi] * ck0 + zk[pi + 1] * ck1 + zk[pi + 2] * ck2, v = zv[pi] * cv0 + zv[pi + 1] * cv1 + zv[pi + 2] * cv2;
              const float kkv = k * kkw; const float ssq = wsum(kkv * kkv); const float kk = kkv * __builtin_amdgcn_rsqf(ssq + 1e-12f);
              const float accw = w0c + resb[pi * 128 + lane], acca = a0c + resb[pi * 128 + 64 + lane];
              uA[pi] = 0.87504273058139731f * sigmoidf_(accw);
              const float a = sigmoidf_(acca);
              const float kd = k * (1.f + (a - 1.f) * kaw);
              const float bon = rowsum16(r * kd * rkw);
              if ((lane & 15) == 0) BON[(((size_t)d * NT + t) * 32 + h) * 4 + (lane >> 4)] = bon;
              kkA[pi] = kk; kkaA[pi] = kk * a; kdA[pi] = kd; rA[pi] = r;
              buf[5 * 512 + pi * 64 + lane] = v;
            }
            { float L = 0.f, Pc = 1.f;
#define PSTEP(pi) do { const float Pp = Pc; L += uA[pi]; Pc = __builtin_amdgcn_exp2f(-L); const float Pi = __builtin_amdgcn_exp2f(L); \
                buf[1 * 512 + (pi) * 64 + lane] = kkA[pi] * Pp; buf[2 * 512 + (pi) * 64 + lane] = kkaA[pi] * Pi; \
                buf[3 * 512 + (pi) * 64 + lane] = kdA[pi] * Pi; buf[4 * 512 + (pi) * 64 + lane] = rA[pi] * Pc; } while (0)
              if (!d) { PSTEP(0); PSTEP(1); PSTEP(2); PSTEP(3); PSTEP(4); PSTEP(5); PSTEP(6); PSTEP(7); }
              else    { PSTEP(7); PSTEP(6); PSTEP(5); PSTEP(4); PSTEP(3); PSTEP(2); PSTEP(1); PSTEP(0); }
#undef PSTEP
              buf[0 * 512 + lane] = Pc; }
            asm volatile("s_waitcnt lgkmcnt(0)" ::: "memory"); __builtin_amdgcn_wave_barrier();
            LORA();
#pragma unroll
            for (int rr = 0; rr < 10; ++rr) { zr[rr] = nzr[rr]; zk[rr] = nzk[rr]; zv[rr] = nzv[rr]; }
          }
          asm volatile("s_waitcnt lgkmcnt(0)" ::: "memory"); __builtin_amdgcn_s_barrier(); asm volatile("" ::: "memory");
        }
#undef LOADM
#undef LOADZ
#undef LORA
      } else {
        const int vg = lane >> 2, kq = lane & 3;
        __builtin_amdgcn_s_setprio(2);
        f32x2 S[4][8];
        const size_t soff = ((size_t)((b * 2 + d) * 32 + h)) * 4096;
        if (samp) { const float* s0 = p.in[I_STATE] + soff;
#pragma unroll
          for (int a = 0; a < 4; ++a)
#pragma unroll
            for (int q = 0; q < 4; ++q) { const f32x4 x = *(const f32x4*)(s0 + (vg * 4 + a) * 64 + kq * 16 + q * 4); S[a][q * 2] = (f32x2){x[0], x[1]}; S[a][q * 2 + 1] = (f32x2){x[2], x[3]}; }
        } else {
#pragma unroll
          for (int a = 0; a < 4; ++a)
#pragma unroll
            for (int q = 0; q < 8; ++q) S[a][q] = (f32x2){0.f, 0.f};
        }
        for (int it = 0; it <= nch; ++it) {
          if (it >= 1) {
            const float* buf = lds + (((it - 1) & 1) * 4 + uw) * 3072;
            const int plo = d ? T - 8 - (it - 1) * 8 : (it - 1) * 8;
            f32x4 kkc[4], vvc;
            { const int slot0 = d ? 7 : 0; const float* bs0 = buf + slot0 * 64 + kq * 16;
#pragma unroll
              for (int q = 0; q < 4; ++q) kkc[q] = *(const f32x4*)(bs0 + 1 * 512 + q * 4);
              vvc = *(const f32x4*)(buf + 5 * 512 + slot0 * 64 + vg * 4); }
#pragma unroll 2
            for (int i = 0; i < 8; ++i) {
              const int slot = d ? 7 - i : i; const size_t t = tb + plo + slot;
              const int i1 = i < 7 ? i + 1 : 7, slotn = d ? 7 - i1 : i1;
              const float* bs = buf + slot * 64 + kq * 16; const float* bn = buf + slotn * 64 + kq * 16;
              f32x4 xka[4], xkd[4], xr[4], kkn[4], vvn;
#pragma unroll
              for (int q = 0; q < 4; ++q) xka[q] = *(const f32x4*)(bs + 2 * 512 + q * 4);
#pragma unroll
              for (int q = 0; q < 4; ++q) { xkd[q] = *(const f32x4*)(bs + 3 * 512 + q * 4); xr[q] = *(const f32x4*)(bs + 4 * 512 + q * 4); }
#pragma unroll
              for (int q = 0; q < 4; ++q) kkn[q] = *(const f32x4*)(bn + 1 * 512 + q * 4);
              vvn = *(const f32x4*)(buf + 5 * 512 + slotn * 64 + vg * 4);
              float sk[4];
#pragma unroll
              for (int a = 0; a < 4; ++a) {
                f32x2 sk2 = S[a][0] * (f32x2){kkc[0][0], kkc[0][1]}, sk3 = S[a][1] * (f32x2){kkc[0][2], kkc[0][3]};
#pragma unroll
                for (int q = 1; q < 4; ++q) { sk2 = __builtin_elementwise_fma(S[a][q * 2], (f32x2){kkc[q][0], kkc[q][1]}, sk2); sk3 = __builtin_elementwise_fma(S[a][q * 2 + 1], (f32x2){kkc[q][2], kkc[q][3]}, sk3); }
                sk2 += sk3;
                float x = sk2[0] + sk2[1]; x += dpp_xor1(x); x += dpp_xor2(x); sk[a] = x;
              }
              float y[4];
#pragma unroll
              for (int a = 0; a < 4; ++a) {
                const f32x2 nsk = (f32x2){-sk[a], -sk[a]}, va = (f32x2){vvc[a], vvc[a]};
                f32x2 y2 = (f32x2){0.f, 0.f}, y3 = (f32x2){0.f, 0.f};
#pragma unroll
                for (int q = 0; q < 4; ++q) {
                  f32x2 s0 = __builtin_elementwise_fma(nsk, (f32x2){xka[q][0], xka[q][1]}, S[a][q * 2]), s1 = __builtin_elementwise_fma(nsk, (f32x2){xka[q][2], xka[q][3]}, S[a][q * 2 + 1]);
                  s0 = __builtin_elementwise_fma(va, (f32x2){xkd[q][0], xkd[q][1]}, s0); s1 = __builtin_elementwise_fma(va, (f32x2){xkd[q][2], xkd[q][3]}, s1);
                  S[a][q * 2] = s0; S[a][q * 2 + 1] = s1;
                  y2 = __builtin_elementwise_fma(s0, (f32x2){xr[q][0], xr[q][1]}, y2); y3 = __builtin_elementwise_fma(s1, (f32x2){xr[q][2], xr[q][3]}, y3);
                }
                y2 += y3;
                float ya = y2[0] + y2[1]; ya += dpp_xor1(ya); ya += dpp_xor2(ya); y[a] = ya;
              }
              const float y01 = (kq & 1) ? y[1] : y[0], y23 = (kq & 1) ? y[3] : y[2];
              YS[((size_t)d * NT + t) * 2048 + h * 64 + lane] = f2bf((kq & 2) ? y23 : y01);
#pragma unroll
              for (int q = 0; q < 4; ++q) kkc[q] = kkn[q];
              vvc = vvn;
            }
#pragma unroll
            for (int q = 0; q < 4; ++q) { const f32x4 pt = *(const f32x4*)(buf + kq * 16 + q * 4);
#pragma unroll
              for (int a = 0; a < 4; ++a) { S[a][q * 2] = S[a][q * 2] * (f32x2){pt[0], pt[1]}; S[a][q * 2 + 1] = S[a][q * 2 + 1] * (f32x2){pt[2], pt[3]}; } }
          }
          asm volatile("s_waitcnt lgkmcnt(0)" ::: "memory"); __builtin_amdgcn_s_barrier(); asm volatile("" ::: "memory");
        }
        __builtin_amdgcn_s_setprio(0);
        if (!samp) { float* sf = p.out + OUT_ST + soff;
#pragma unroll
          for (int a = 0; a < 4; ++a)
#pragma unroll
            for (int q = 0; q < 4; ++q) { f32x4 x = {S[a][q * 2][0], S[a][q * 2][1], S[a][q * 2 + 1][0], S[a][q * 2 + 1][1]}; *(f32x4*)(sf + (vg * 4 + a) * 64 + kq * 16 + q * 4) = x; }
        }
      }
    }
  }
}

__device__ __forceinline__ void rwkv_fin_phase(const Params& p) {
  int tid_ = threadIdx.x; asm volatile("" : "+v"(tid_));
  const int tid = tid_, wid = __builtin_amdgcn_readfirstlane(tid >> 6), lane = tid & 63, fr = lane & 15, fq = lane >> 4, G = gridDim.x;
  const bf16_t* ZRKV = (const bf16_t*)(p.ws + OFF_ZRKV);
  const float* MISC = (const float*)(p.ws + OFF_MISC);
  const float* BON = (const float*)(p.ws + OFF_BON);
  const bf16_t* YS = (const bf16_t*)p.out;
  bf16_t* ORW = (bf16_t*)(p.ws + OFF_ORWKV);
  bf16_t* st16 = (bf16_t*)smem;
  float* cst = (float*)(smem + 17408);
  float* gt = (float*)(smem + 18688) + wid * (16 * 68);
  const int tt = lane >> 2, cg = lane & 3;
  for (int job = blockIdx.x; job < 256; job += G) {
    const int h = job & 31, tr = job >> 5;
    __syncthreads();
#pragma unroll 4
    for (int i = 0; i < 16; ++i) { const int idx = tid + i * 512, j = idx >> 6, c = idx & 63; st16[c * 136 + j] = f2bf(p.in[I_GUP][(size_t)j * 2048 + h * 64 + c]); }
    if (tid < 320) { const int w = tid >> 6, c = tid & 63; const int hc = h * 64 + c;
      cst[tid] = w == 0 ? p.in[I_LNXW][hc] : w == 1 ? p.in[I_LNXB][hc] : p.in[I_CONV][(w - 2) * 6144 + 4096 + hc]; }
    __syncthreads();
    bf16x8 bg[4][4];
#pragma unroll
    for (int ks = 0; ks < 4; ++ks)
#pragma unroll
      for (int nt = 0; nt < 4; ++nt) bg[ks][nt] = *(const bf16x8*)(st16 + (nt * 16 + fr) * 136 + ks * 32 + fq * 8);
#pragma unroll 1
    for (int i = 0; i < 16; ++i) {
      const int t0 = tr * 2048 + (wid * 16 + i) * 16;
      const size_t t = t0 + tt;
      const int pos = t < NPR ? (int)(t & 255) : (int)((t - NPR) & 1023), T = t < NPR ? 256 : 1024;
      const bool hasm = pos > 0, hasp = pos < T - 1;
      const bf16_t* y0p = YS + t * 2048 + h * 64 + cg * 16; const bf16_t* y1p = y0p + (size_t)NT * 2048;
      const bf16_t* zc = ZRKV + t * 6144 + h * 192 + 128 + cg * 16; const bf16_t* zm = hasm ? zc - 6144 : zc; const bf16_t* zp = hasp ? zc + 6144 : zc;
      u32x4 ya[2], yb[2], z0[2], z1[2], z2[2];
#pragma unroll
      for (int q = 0; q < 2; ++q) { ya[q] = *(const u32x4*)(y0p + q * 8); yb[q] = *(const u32x4*)(y1p + q * 8);
        z0[q] = *(const u32x4*)(zm + q * 8); z1[q] = *(const u32x4*)(zc + q * 8); z2[q] = *(const u32x4*)(zp + q * 8); }
      const f32x4 b0 = *(const f32x4*)(BON + (t * 32 + h) * 4), b1 = *(const f32x4*)(BON + (((size_t)NT + t) * 32 + h) * 4);
      f32x4 mx[4][2];
      { const float* mp = MISC + (size_t)(t0 + fr) * 512 + 320 + fq * 8;
#pragma unroll
        for (int ks = 0; ks < 4; ++ks) { mx[ks][0] = *(const f32x4*)(mp + ks * 32); mx[ks][1] = *(const f32x4*)(mp + ks * 32 + 4); } }
      __builtin_amdgcn_sched_barrier(0);
      bf16x8 ag[4];
#pragma unroll
      for (int ks = 0; ks < 4; ++ks) { float x[8];
#pragma unroll
        for (int e = 0; e < 4; ++e) { x[e] = sigmoidf_(mx[ks][0][e]); x[4 + e] = sigmoidf_(mx[ks][1][e]); }
        ag[ks] = pack8(x); }
#pragma unroll
      for (int nt = 0; nt < 4; ++nt) { f32x4 g = (f32x4){0.f, 0.f, 0.f, 0.f};
#pragma unroll
        for (int ks = 0; ks < 4; ++ks) g = __builtin_amdgcn_mfma_f32_16x16x32_bf16(ag[ks], bg[ks][nt], g, 0, 0, 0);
#pragma unroll
        for (int e = 0; e < 4; ++e) gt[(fq * 4 + e) * 68 + nt * 16 + fr] = g[e]; }
      asm volatile("s_waitcnt lgkmcnt(0)" ::: "memory"); __builtin_amdgcn_wave_barrier();
      float y[16]; float sum = 0.f;
#pragma unroll
      for (int q = 0; q < 2; ++q)
#pragma unroll
        for (int e = 0; e < 4; ++e) { const unsigned a = ya[q][e], b = yb[q][e];
          y[q * 8 + 2 * e] = __uint_as_float(a << 16) + __uint_as_float(b << 16); y[q * 8 + 2 * e + 1] = __uint_as_float(a & 0xffff0000u) + __uint_as_float(b & 0xffff0000u); }
#pragma unroll
      for (int c = 0; c < 16; ++c) sum += y[c];
      sum += dpp_xor1(sum); sum += dpp_xor2(sum);
      const float mu = sum * (1.f / 64.f);
      float qq = 0.f;
#pragma unroll
      for (int c = 0; c < 16; ++c) { y[c] -= mu; qq += y[c] * y[c]; }
      qq += dpp_xor1(qq); qq += dpp_xor2(qq);
      const float rstd = rsqrtf(qq * (1.f / 64.f) + 64e-5f);
      const float bon = (b0[0] + b0[1]) + (b0[2] + b0[3]) + (b1[0] + b1[1]) + (b1[2] + b1[3]);
      u32x4 outv[2];
#pragma unroll
      for (int q = 0; q < 2; ++q) { float o[8];
#pragma unroll
        for (int e4 = 0; e4 < 2; ++e4) { const int cb = q * 8 + e4 * 4;
          const f32x4 gv = *(const f32x4*)(gt + tt * 68 + cg * 16 + cb);
          const f32x4 lw = *(const f32x4*)(cst + 0 * 64 + cg * 16 + cb), lb = *(const f32x4*)(cst + 1 * 64 + cg * 16 + cb);
          const f32x4 k0 = *(const f32x4*)(cst + 2 * 64 + cg * 16 + cb), k1 = *(const f32x4*)(cst + 3 * 64 + cg * 16 + cb), k2 = *(const f32x4*)(cst + 4 * 64 + cg * 16 + cb);
#pragma unroll
          for (int e = 0; e < 4; ++e) { const int c = e4 * 4 + e; const int w = c >> 1;
            const unsigned um = z0[q][w], uc = z1[q][w], up = z2[q][w];
            const float vm = (c & 1) ? __uint_as_float(um & 0xffff0000u) : __uint_as_float(um << 16);
            const float vc = (c & 1) ? __uint_as_float(uc & 0xffff0000u) : __uint_as_float(uc << 16);
            const float vp = (c & 1) ? __uint_as_float(up & 0xffff0000u) : __uint_as_float(up << 16);
            const float v = (hasm ? vm : 0.f) * k0[e] + vc * k1[e] + (hasp ? vp : 0.f) * k2[e];
            o[c] = (y[q * 8 + c] * rstd * lw[e] + lb[e] + bon * v) * gv[e]; } }
        outv[q] = (u32x4){cvtpk(o[0], o[1]), cvtpk(o[2], o[3]), cvtpk(o[4], o[5]), cvtpk(o[6], o[7])}; }
      bf16_t* op = ORW + t * 2048 + h * 64 + cg * 16;
      *(u32x4*)op = outv[0]; *(u32x4*)(op + 8) = outv[1];
      asm volatile("s_waitcnt lgkmcnt(0)" ::: "memory"); __builtin_amdgcn_wave_barrier();
    }
  }
  { const float* zckv = (const float*)(p.ws + OFF_ZCKV); const float* kvn = p.in[I_KVNORM]; bf16_t* ckvn = (bf16_t*)(p.ws + OFF_CKVN);
    const f32x4 g0 = *(const f32x4*)(kvn + lane * 8), g1 = *(const f32x4*)(kvn + lane * 8 + 4);
    const int stride = G * 8;
    for (int r0 = blockIdx.x * 8 + wid; r0 < NT; r0 += 4 * stride) {
      f32x4 a[4], b[4];
#pragma unroll
      for (int u = 0; u < 4; ++u) { const int r = r0 + u * stride < NT ? r0 + u * stride : r0; const float* xr = zckv + (size_t)r * 512 + lane * 8; a[u] = *(const f32x4*)xr; b[u] = *(const f32x4*)(xr + 4); }
      __builtin_amdgcn_sched_barrier(0);
#pragma unroll
      for (int u = 0; u < 4; ++u) { const int r = r0 + u * stride; if (r >= NT) break;
        float ss = 0; for (int i = 0; i < 4; ++i) ss += a[u][i] * a[u][i] + b[u][i] * b[u][i];
        ss = wsum(ss); const float rs = rsqrtf(ss * (1.f / 512.f) + 1e-6f);
        const f32x4 x = a[u] * rs * g0, y = b[u] * rs * g1;
        u32x4 o = {cvtpk(x[0], x[1]), cvtpk(x[2], x[3]), cvtpk(y[0], y[1]), cvtpk(y[2], y[3])};
        *(u32x4*)(ckvn + (size_t)r * 512 + lane * 8) = o; }
    } }
}

__device__ __forceinline__ void kfin_phase(const Params& p) {
  const int tid = otid(), wid = tid >> 6, lane = tid & 63, fr = lane & 15, fq = lane >> 4;
  bf16_t* Kb = (bf16_t*)(p.ws + OFF_K);
  const float* MISC = (const float*)(p.ws + OFF_MISC);
  const float* rope = (const float*)(p.ws + OFF_ROPE);
  const float* knw = p.in[I_KNORM];
  const f32x4 gn0 = *(const f32x4*)(knw + fr * 8), gn1 = *(const f32x4*)(knw + fr * 8 + 4), gr = *(const f32x4*)(knw + 128 + fr * 4);
  const int axis = fr >> 3, second = (fr >> 2) & 1, pp0 = (fr & 3) * 4;
  const int njobs = 18432 * 4, stride = gridDim.x * 8;
  for (int job0 = blockIdx.x * 8 + wid; job0 < njobs; job0 += stride * 4) {
    u32x4 raw[4]; f32x4 krv[4]; bf16_t* kp[4]; int tposv[4]; bool ropev[4], valid[4];
#pragma unroll
    for (int u = 0; u < 4; ++u) {
      const int job = job0 + u * stride; valid[u] = job < njobs; const int jc = valid[u] ? job : job0;
      const int r = jc >> 2, h = (jc & 3) * 4 + fq;
      size_t krow; const float* krp; ropev[u] = false; tposv[u] = 0;
      if (r < NPR) { krow = (size_t)((r >> 8) * 16 + h) * 256 + (r & 255); krp = MISC + (size_t)r * 512; }
      else if (r < NT) { const int rr = r - NPR; krow = 131072 + (size_t)((rr >> 10) * 16 + h) * 1280 + (rr & 1023); krp = MISC + (size_t)r * 512; ropev[u] = true; tposv[u] = rr & 1023; }
      else { const int rr = r - NT; krow = 131072 + (size_t)((rr >> 8) * 16 + h) * 1280 + 1024 + (rr & 255); krp = p.in[I_CKR] + (size_t)rr * 64; }
      kp[u] = Kb + krow * 192;
      raw[u] = *(const u32x4*)(kp[u] + fr * 8); krv[u] = *(const f32x4*)(krp + fr * 4);
    }
    __builtin_amdgcn_sched_barrier(0);
#pragma unroll
    for (int u = 0; u < 4; ++u) {
      float n[8];
#pragma unroll
      for (int i = 0; i < 4; ++i) { n[2 * i] = __uint_as_float(raw[u][i] << 16); n[2 * i + 1] = __uint_as_float(raw[u][i] & 0xffff0000u); }
      float ss = 0.f;
#pragma unroll
      for (int i = 0; i < 8; ++i) ss += n[i] * n[i];
#pragma unroll
      for (int i = 0; i < 4; ++i) ss += krv[u][i] * krv[u][i];
      ss = rowsum16(ss);
      const float rs = __builtin_amdgcn_rsqf(ss * (1.f / 192.f) + 1e-6f);
      u32x4 o = {cvtpk(n[0] * rs * gn0[0], n[1] * rs * gn0[1]), cvtpk(n[2] * rs * gn0[2], n[3] * rs * gn0[3]),
                 cvtpk(n[4] * rs * gn1[0], n[5] * rs * gn1[1]), cvtpk(n[6] * rs * gn1[2], n[7] * rs * gn1[3])};
      f32x4 x = krv[u] * rs * gr, pr;
#pragma unroll
      for (int i = 0; i < 4; ++i) pr[i] = __shfl_xor(x[i], 4);
      if (ropev[u]) { const int pos = axis ? (tposv[u] & 63) : (tposv[u] >> 6);
#pragma unroll
        for (int i = 0; i < 4; ++i) { const float cs = rope[(pos * 16 + pp0 + i) * 2], sn = rope[(pos * 16 + pp0 + i) * 2 + 1];
          x[i] = second ? x[i] * cs + pr[i] * sn : x[i] * cs - pr[i] * sn; } }
      if (valid[u]) { *(u32x4*)(kp[u] + fr * 8) = o; u32x2 ro = {cvtpk(x[0], x[1]), cvtpk(x[2], x[3])}; *(u32x2*)(kp[u] + 128 + fr * 4) = ro; }
    }
  }
}

constexpr float ATT_SCALE = 0.07216878364870322f;
constexpr float ATT_THR = 8.f;
constexpr int SHM_V = 64 * 128 * 2, SHM_K = 64 * 192 * 2;
#define KSWZ(row, colB) ((row) * 384 + ((colB) ^ (((row) & 7) << 4)))
#define SBAR() __builtin_amdgcn_sched_barrier(0)
__device__ __forceinline__ int crow(int r, int hi) { return (r & 3) + 8 * (r >> 2) + 4 * hi; }
__device__ __forceinline__ void partialSM(f32x16& p0, f32x16& p1, float& m_reg, float& mn, float& alpha) {
  constexpr float C = ATT_SCALE * 1.4426950408889634f;
  float pmax = p0[0]; for (int r = 1; r < 16; ++r) pmax = fmaxf(pmax, p0[r]); for (int r = 0; r < 16; ++r) pmax = fmaxf(pmax, p1[r]);
  { auto rr = __builtin_amdgcn_permlane32_swap(__float_as_uint(pmax), __float_as_uint(pmax), false, false);
    pmax = fmaxf(__uint_as_float(rr[0]), __uint_as_float(rr[1])); }
  if (__builtin_expect(__all(pmax - m_reg <= ATT_THR / ATT_SCALE), 1)) { mn = m_reg; alpha = 1.f; }
  else { mn = fmaxf(m_reg, pmax); alpha = __builtin_amdgcn_exp2f((m_reg - mn) * C); m_reg = mn; }
  float mnC = -mn * C;
  for (int r = 0; r < 16; ++r) p0[r] = fmaf(p0[r], C, mnC); for (int r = 0; r < 16; ++r) p1[r] = fmaf(p1[r], C, mnC);
  for (int r = 0; r < 16; ++r) p0[r] = __builtin_amdgcn_exp2f(p0[r]);
}
__device__ __forceinline__ void finishSM(f32x16& p0, f32x16& p1, float alpha, float& l_reg, bf16x8& pa0, bf16x8& pa1, bf16x8& pa2, bf16x8& pa3) {
  for (int r = 0; r < 16; ++r) p1[r] = __builtin_amdgcn_exp2f(p1[r]);
  float ps = 0; for (int r = 0; r < 16; ++r) ps += p0[r]; for (int r = 0; r < 16; ++r) ps += p1[r];
  { auto rr = __builtin_amdgcn_permlane32_swap(__float_as_uint(ps), __float_as_uint(ps), false, false);
    ps = __uint_as_float(rr[0]) + __uint_as_float(rr[1]); }
  l_reg = l_reg * alpha + ps;
#define PK4(P, BASE, OUT) do { unsigned a0 = cvtpk(P[BASE + 0], P[BASE + 1]), a1 = cvtpk(P[BASE + 2], P[BASE + 3]);   \
    unsigned b0 = cvtpk(P[BASE + 4], P[BASE + 5]), b1 = cvtpk(P[BASE + 6], P[BASE + 7]);                              \
    auto r0 = __builtin_amdgcn_permlane32_swap(a0, b0, false, false); auto r1 = __builtin_amdgcn_permlane32_swap(a1, b1, false, false); \
    u32x4 w = {r0[0], r1[0], r0[1], r1[1]}; OUT = *reinterpret_cast<bf16x8*>(&w); } while (0)
  PK4(p0, 0, pa0); PK4(p0, 8, pa1); PK4(p1, 0, pa2); PK4(p1, 8, pa3);
#undef PK4
}
__device__ __forceinline__ void qkt(f32x16& p0, f32x16& p1, const char* Ks, const bf16x8* qr, int r32, int hi) {
  p0 = f32x16{}; p1 = f32x16{};
  bf16x8 ka[3], kb[3];
#define KLD(d0, slot) do { const int cb_ = ((d0) * 16 + hi * 8) * 2; ka[slot] = *reinterpret_cast<const bf16x8*>(Ks + KSWZ(r32, cb_)); kb[slot] = *reinterpret_cast<const bf16x8*>(Ks + KSWZ(32 + r32, cb_)); } while (0)
  KLD(0, 0); KLD(1, 1); __builtin_amdgcn_sched_barrier(0);
#pragma unroll
  for (int d0 = 0; d0 < 12; ++d0) {
    if (d0 + 2 < 12) KLD(d0 + 2, (d0 + 2) % 3);
    __builtin_amdgcn_sched_barrier(0);
    p0 = __builtin_amdgcn_mfma_f32_32x32x16_bf16(ka[d0 % 3], qr[d0], p0, 0, 0, 0);
    p1 = __builtin_amdgcn_mfma_f32_32x32x16_bf16(kb[d0 % 3], qr[d0], p1, 0, 0, 0);
    __builtin_amdgcn_sched_barrier(0); }
#undef KLD
}
__device__ __forceinline__ int v_st(int k, int c) { const int kk = (k & ~0xC) | ((k & 4) << 1) | ((k & 8) >> 1); return ((kk >> 3) * 4 + (c >> 5)) * 512 + ((kk & 7) * 32 + (c & 31)) * 2; }
__device__ __forceinline__ int v_rd_base(int lane) { return ((lane & 3) << 3) | (((lane >> 2) & 3) << 6) | (((lane >> 4) & 1) << 5) | (((lane >> 5) & 1) << 8); }
constexpr int v_rd_off(int d0, int ks, int half) { return d0 * 512 + ks * 4096 + half * 2048; }
template <int OFF> __device__ __forceinline__ s16x4 tr_read(int vb) {
  s16x4 r; asm volatile("ds_read_b64_tr_b16 %0, %1 offset:%2" : "=&v"(r) : "v"(vb), "i"(OFF) : "memory"); return r;
}
template <int D0> __device__ __forceinline__ void pv_one(f32x16& od, int vb, bf16x8 pa0, bf16x8 pa1, bf16x8 pa2, bf16x8 pa3) {
  const s16x4 l0 = tr_read<v_rd_off(D0, 0, 0)>(vb), h0 = tr_read<v_rd_off(D0, 0, 1)>(vb), l1 = tr_read<v_rd_off(D0, 1, 0)>(vb), h1 = tr_read<v_rd_off(D0, 1, 1)>(vb);
  const s16x4 l2 = tr_read<v_rd_off(D0, 2, 0)>(vb), h2 = tr_read<v_rd_off(D0, 2, 1)>(vb), l3 = tr_read<v_rd_off(D0, 3, 0)>(vb), h3 = tr_read<v_rd_off(D0, 3, 1)>(vb);
  asm volatile("s_waitcnt lgkmcnt(0)" ::: "memory"); SBAR();
#define PK(L, H) (bf16x8){L[0], L[1], L[2], L[3], H[0], H[1], H[2], H[3]}
  od = __builtin_amdgcn_mfma_f32_32x32x16_bf16(pa0, PK(l0, h0), od, 0, 0, 0);
  od = __builtin_amdgcn_mfma_f32_32x32x16_bf16(pa1, PK(l1, h1), od, 0, 0, 0);
  od = __builtin_amdgcn_mfma_f32_32x32x16_bf16(pa2, PK(l2, h2), od, 0, 0, 0);
  od = __builtin_amdgcn_mfma_f32_32x32x16_bf16(pa3, PK(l3, h3), od, 0, 0, 0);
#undef PK
}
__device__ __forceinline__ void pv_d0(f32x16* o, int vb, bf16x8 pa0, bf16x8 pa1, bf16x8 pa2, bf16x8 pa3) {
  pv_one<0>(o[0], vb, pa0, pa1, pa2, pa3); pv_one<1>(o[1], vb, pa0, pa1, pa2, pa3); pv_one<2>(o[2], vb, pa0, pa1, pa2, pa3); pv_one<3>(o[3], vb, pa0, pa1, pa2, pa3);
}

__device__ __forceinline__ void attn_unit(const bf16_t* __restrict__ Qb, const bf16_t* __restrict__ Kh, const bf16_t* __restrict__ Vh, bf16_t* __restrict__ Ob,
                                          const int seq, const float* __restrict__ qnw, const bool dorope, const int tpos0, const float* __restrict__ rope) {
  char* lds = smem;
  int tid_ = threadIdx.x; asm volatile("" : "+v"(tid_));
  const int tid = tid_, wid = tid >> 6, lane = tid & 63, r32 = lane & 31, hi = lane >> 5;
  char* V_lds = lds; char* K_lds = lds + 2 * SHM_V;
  float* wsf = (float*)(lds + 2 * SHM_V + 2 * SHM_K) + wid * 64; float* li_l = wsf; float* al_l = wsf + 32;
  float m_reg = -1e30f, l_reg = 0; bf16x8 qr[12];
  __syncthreads();
  {
    const bf16_t* Qw = Qb + (size_t)(wid * 32 + r32) * 3072 + hi * 8;
    float ss = 0.f;
#pragma unroll
    for (int d0 = 0; d0 < 12; ++d0) { const bf16x8 raw = *(const bf16x8*)(Qw + d0 * 16);
#pragma unroll
      for (int e = 0; e < 8; ++e) { const float x = bf2f((bf16_t)raw[e]); ss += x * x; } }
    ss += __shfl_xor(ss, 32);
    const float rs = rsqrtf(ss * (1.f / 192.f) + 1e-6f);
    const int tpos = tpos0 + wid * 32 + r32;
    asm volatile("" ::: "memory");
#pragma unroll
    for (int d0 = 0; d0 < 12; d0 += 2) {
      const bf16x8 ra = *(const volatile bf16x8*)(Qw + d0 * 16), rb = *(const volatile bf16x8*)(Qw + d0 * 16 + 16);
      float xa[8], xb[8];
#pragma unroll
      for (int e = 0; e < 8; ++e) { xa[e] = bf2f((bf16_t)ra[e]) * rs * qnw[d0 * 16 + hi * 8 + e]; xb[e] = bf2f((bf16_t)rb[e]) * rs * qnw[(d0 + 1) * 16 + hi * 8 + e]; }
      if (d0 >= 8 && dorope) {
        const int pos = d0 == 8 ? (tpos >> 6) : (tpos & 63);
#pragma unroll
        for (int e = 0; e < 8; ++e) { const int pp = hi * 8 + e; const float cs = rope[(pos * 16 + pp) * 2], sn = rope[(pos * 16 + pp) * 2 + 1];
          const float x1 = xa[e], x2 = xb[e]; xa[e] = x1 * cs - x2 * sn; xb[e] = x2 * cs + x1 * sn; }
      }
      u32x4 wa = {cvtpk(xa[0], xa[1]), cvtpk(xa[2], xa[3]), cvtpk(xa[4], xa[5]), cvtpk(xa[6], xa[7])};
      u32x4 wb = {cvtpk(xb[0], xb[1]), cvtpk(xb[2], xb[3]), cvtpk(xb[4], xb[5]), cvtpk(xb[6], xb[7])};
      qr[d0] = *reinterpret_cast<bf16x8*>(&wa); qr[d0 + 1] = *reinterpret_cast<bf16x8*>(&wb);
    }
  }
  f32x16 o[4] = {};
  const int sr = tid >> 4, sc = (tid & 15) * 8, vst0 = v_st(sr, sc), vst1 = v_st(32 + sr, sc);
  const int kc0 = tid, kc1 = tid + 512, kc2 = tid + 1024;
  const int kr0 = kc0 / 24, kq0 = kc0 % 24, kr1 = kc1 / 24, kq1 = kc1 % 24, kr2 = kc2 / 24, kq2 = kc2 % 24;
  const int vb0 = (int)(uintptr_t)V_lds + v_rd_base(lane);
  bf16x8 vs0, vs1, ks0, ks1, ks2;
#define SLOAD(k0) do { vs0 = *(const bf16x8*)(Vh + (size_t)((k0) + sr) * 128 + sc); vs1 = *(const bf16x8*)(Vh + (size_t)((k0) + 32 + sr) * 128 + sc); \
    ks0 = *(const bf16x8*)(Kh + (size_t)((k0) + kr0) * 192 + kq0 * 8); ks1 = *(const bf16x8*)(Kh + (size_t)((k0) + kr1) * 192 + kq1 * 8); \
    ks2 = *(const bf16x8*)(Kh + (size_t)((k0) + kr2) * 192 + kq2 * 8); } while (0)
#define SWRITE(b) do { *(bf16x8*)(V_lds + (b) * SHM_V + vst0) = vs0; *(bf16x8*)(V_lds + (b) * SHM_V + vst1) = vs1; \
    *(bf16x8*)(K_lds + (b) * SHM_K + KSWZ(kr0, kq0 * 16)) = ks0; *(bf16x8*)(K_lds + (b) * SHM_K + KSWZ(kr1, kq1 * 16)) = ks1; \
    *(bf16x8*)(K_lds + (b) * SHM_K + KSWZ(kr2, kq2 * 16)) = ks2; } while (0)
  const int NTL = seq / 64;
  SLOAD(0); SWRITE(0);
  f32x16 p0, p1; float mn, al; bf16x8 pa0, pa1, pa2, pa3;
  for (int j = 0; j < NTL; ++j) {
    const int bsel = j & 1;
    __syncthreads();
    if (j + 1 < NTL) SLOAD((j + 1) * 64);
    SBAR();
    qkt(p0, p1, K_lds + bsel * SHM_K, qr, r32, hi);
    partialSM(p0, p1, m_reg, mn, al);
    if (__any(al < 1.f)) { if (hi == 0) al_l[r32] = al; asm volatile("s_waitcnt lgkmcnt(0)" ::: "memory");
#pragma unroll
      for (int d = 0; d < 4; ++d)
#pragma unroll
        for (int r = 0; r < 16; ++r) o[d][r] *= al_l[crow(r, hi)]; }
    finishSM(p0, p1, al, l_reg, pa0, pa1, pa2, pa3); SBAR();
    pv_d0(o, vb0 + bsel * SHM_V, pa0, pa1, pa2, pa3);
    if (j + 1 < NTL) SWRITE(bsel ^ 1);
  }
  if (hi == 0) li_l[r32] = l_reg; asm volatile("s_waitcnt lgkmcnt(0)" ::: "memory");
  float rli[16];
#pragma unroll
  for (int r = 0; r < 16; ++r) rli[r] = __builtin_amdgcn_rcpf(li_l[crow(r, hi)]);
  bf16_t* Ow = Ob + (size_t)(wid * 32) * 2048;
#pragma unroll
  for (int r = 0; r < 16; ++r) { const int orow = crow(r, hi);
#pragma unroll
    for (int d0 = 0; d0 < 4; ++d0) Ow[(size_t)orow * 2048 + d0 * 32 + r32] = f2bf(o[d0][r] * rli[r]); }
#undef SLOAD
#undef SWRITE
}

__device__ __forceinline__ void attn_phase(const Params& p) {
  const bf16_t* ZQ = (const bf16_t*)(p.ws + OFF_ZQ); const bf16_t* Kb = (const bf16_t*)(p.ws + OFF_K); const bf16_t* Vb = (const bf16_t*)(p.ws + OFF_V);
  bf16_t* OM = (bf16_t*)(p.ws + OFF_OMLA); const float* rope = (const float*)(p.ws + OFF_ROPE);
  for (int u = blockIdx.x; u < 1024; u += gridDim.x) {
    if (u < 512) { const int b = u >> 6, h = (u >> 2) & 15, qb = u & 3; const size_t t0 = NPR + b * 1024 + qb * 256, kr = 131072 + (size_t)(b * 16 + h) * 1280;
      attn_unit(ZQ + t0 * 3072 + h * 192, Kb + kr * 192, Vb + kr * 128, OM + t0 * 2048 + h * 128, 1280, p.in[I_QNORM], true, qb * 256, rope); }
    else { const int up = u - 512, b = up >> 4, h = up & 15; const size_t t0 = b * 256, kr = (size_t)(b * 16 + h) * 256;
      attn_unit(ZQ + t0 * 3072 + h * 192, Kb + kr * 192, Vb + kr * 128, OM + t0 * 2048 + h * 128, 256, p.in[I_QNORM], false, 0, rope); }
  }
}

__device__ __forceinline__ void ffconv_phase(const Params& p) {
  conv_loop([&p](int j, int sb) { CJob c;
    if (j < 1024) { const int nt4 = j >> 5, kb = j & 31; c.src = p.in[I_WFFIN]; c.dst = (bf16_t*)(p.ws + OFF_WTFFIN); c.Nsrc = 8192; c.K = 2048; c.k0 = kb * 64; c.sc = nt4 * 256 + sb * 64; c.dstn0 = nt4 * 256; }
    else { const int jj = j - 1024, nt4 = jj >> 7, kb = jj & 127; c.src = p.in[I_WFFOUT]; c.dst = (bf16_t*)(p.ws + OFF_WTFFOUT); c.Nsrc = 2048; c.K = 8192; c.k0 = kb * 64; c.sc = nt4 * 256 + sb * 64; c.dstn0 = nt4 * 256; }
    return c; }, 2048);
}

#define XB_TMO      128
#define XB_XCNT(j)  (256  + 64 * (j))
#define XB_XSUB(j)  (1280 + 64 * (j))
#define XB_XGEN(j)  (2304 + 64 * (j))
#define XB_TOP      3328
#define XB_TOPGEN   3392
#define XCD_BAR_WORDS 3456
#define XB_SPIN_CAP (1u << 18)
__device__ __forceinline__ unsigned xb_ld(unsigned* p)              { return __hip_atomic_load(p, __ATOMIC_RELAXED, __HIP_MEMORY_SCOPE_AGENT); }
__device__ __forceinline__ unsigned xb_add(unsigned* p, unsigned v) { return __hip_atomic_fetch_add(p, v, __ATOMIC_RELAXED, __HIP_MEMORY_SCOPE_AGENT); }
__device__ __forceinline__ unsigned xb_xcc_id() { return (unsigned)__builtin_amdgcn_s_getreg((3 << 11) | 20) & 0xFu; }
#define XB_SPIN(cond, bar) do { unsigned _sp = 0; while (cond) { __builtin_amdgcn_s_sleep(1); \
    if ((++_sp & 255u) == 0u) { if (xb_ld(&(bar)[XB_TMO])) break; if (_sp > XB_SPIN_CAP) { atomicAdd(&(bar)[XB_TMO], 1u); break; } } } } while (0)
struct XcdBarrier { unsigned* bar; unsigned x; volatile LAS unsigned* st; };
__device__ __forceinline__ XcdBarrier xcd_barrier_post(unsigned* bar, volatile LAS unsigned* st) {
  XcdBarrier b; b.bar = bar; b.x = xb_xcc_id(); b.st = st;
  if (threadIdx.x == 0) (void)xb_add(&bar[XB_XCNT(b.x)], 1u);
  return b;
}
__device__ __forceinline__ void xcd_barrier_complete(unsigned* bar, unsigned x, unsigned& nloc, unsigned& nx) {
  const unsigned G = gridDim.x * gridDim.y * gridDim.z;
  unsigned sum, cnt, mine, sp = 0u;
  for (;;) {
    sum = 0u; cnt = 0u; mine = 0u;
#pragma unroll
    for (unsigned j = 0; j < 16; ++j) { const unsigned c = xb_ld(&bar[XB_XCNT(j)]); sum += c; cnt += (c > 0u) ? 1u : 0u; mine = (j == x) ? c : mine; }
    if (sum == G) break;
    __builtin_amdgcn_s_sleep(1);
    if ((++sp & 255u) == 0u) { if (xb_ld(&bar[XB_TMO])) break; if (sp > XB_SPIN_CAP) { atomicAdd(&bar[XB_TMO], 1u); break; } }
  }
  nloc = mine > 0u ? mine : 1u; nx = cnt > 0u ? cnt : 1u;
}
__device__ __forceinline__ void xcd_barrier(const XcdBarrier& b) {
  asm volatile("s_waitcnt vmcnt(0)" ::: "memory");
  __syncthreads();
  if (threadIdx.x == 0) {
    unsigned* bar = b.bar;
    __builtin_amdgcn_s_waitcnt(0);
    unsigned nloc = b.st[0], nx = b.st[1];
    if (nloc == 0u) { xcd_barrier_complete(bar, b.x, nloc, nx); b.st[0] = nloc; b.st[1] = nx; }
    const unsigned old = xb_add(&bar[XB_XSUB(b.x)], 1u);
    const unsigned gen = old / nloc;
    if (old + 1u == (gen + 1u) * nloc) {
      __builtin_amdgcn_fence(__ATOMIC_RELEASE, "agent");
      asm volatile("s_waitcnt vmcnt(0)" ::: "memory");
      const unsigned og = xb_add(&bar[XB_TOP], 1u);
      const unsigned tg = og / nx;
      if (og + 1u == (tg + 1u) * nx) xb_add(&bar[XB_TOPGEN], 1u);
      else XB_SPIN(xb_ld(&bar[XB_TOPGEN]) == tg, bar);
      __builtin_amdgcn_fence(__ATOMIC_ACQUIRE, "agent");
      xb_add(&bar[XB_XGEN(b.x)], 1u);
      asm volatile("s_waitcnt vmcnt(0)" ::: "memory");
    } else {
      XB_SPIN(xb_ld(&bar[XB_XGEN(b.x)]) == gen, bar);
      __builtin_amdgcn_fence(__ATOMIC_ACQUIRE, "agent");
      asm volatile("s_waitcnt vmcnt(0)" ::: "memory");
    }
  }
  __syncthreads();
}

__global__ void __launch_bounds__(512, 2) fwd_megakernel(Params p, int ph_lo, int ph_hi) {
  cg::grid_group grid = cg::this_grid();
  char* ws = p.ws;
  __shared__ uint4 xb_words;
  if (threadIdx.x == 0) xb_words = make_uint4(0u, 0u, 0u, 0u);
  __syncthreads();
  const XcdBarrier xb = xcd_barrier_post((unsigned*)(ws + OFF_XBAR), (volatile LAS unsigned*)&xb_words);
  if (ph_hi > 1000) grid.sync();
  const float* mod = (const float*)(ws + OFF_MOD);
#ifndef PHMASK
#define PHMASK 0xffff
#endif
#define ON(n) ((PHMASK >> (n)) & 1)
#ifndef DUPMASK
#define DUPMASK 0
#endif
#define PHASE(n, ...) if (ON(n) && ph_lo <= (n) && (n) < ph_hi) { __VA_ARGS__; if ((n) + 1 < ph_hi) xcd_barrier(xb); }
  PHASE(0, phase0(p))
  PHASE(1, norm_mod_phase<false>(p.in[I_XP], p.in[I_XS], p.in[I_NORM1], mod, 0, 1, (bf16_t*)(ws + OFF_H)))
  PHASE(2, { EpiIn1 e{(bf16_t*)(ws + OFF_ZRKV), (float*)(ws + OFF_ZCKV), (float*)(ws + OFF_MISC), p.out};
             gemm_phase((const bf16_t*)(ws + OFF_H), (const bf16_t*)(ws + OFF_WTIN), 2048, 64, 28, e); })
  PHASE(3, scan_phase(p))
  PHASE(4, rwkv_fin_phase(p))
  PHASE(5, { EpiIn2 e{(bf16_t*)(ws + OFF_ZQ), (bf16_t*)p.out};
             gemm_phase((const bf16_t*)(ws + OFF_H), (const bf16_t*)(ws + OFF_WTIN) + (size_t)7168 * 2048, 2048, 64, 28, e); })
  PHASE(6, { EpiKV e{(bf16_t*)(ws + OFF_K), (bf16_t*)(ws + OFF_V), 0, 0, 0};
             gemm_phase((const bf16_t*)(ws + OFF_CKVN), (const bf16_t*)(ws + OFF_WTKV), 512, 72, 16, e); })
  PHASE(7, kfin_phase(p))
  PHASE(8, attn_phase(p))
  PHASE(9, { EpiMerge e{(bf16_t*)(ws + OFF_MERGED), (const bf16_t*)p.out};
             gemm_phase((const bf16_t*)(ws + OFF_OMLA), (const bf16_t*)(ws + OFF_WTBRM), 2048, 64, 8, e, (const bf16_t*)(ws + OFF_ORWKV), (const bf16_t*)(ws + OFF_WTBRR)); })
  PHASE(10, { EpiOut e{p.in[I_XP], p.in[I_XS], mod, (bf16_t*)(ws + OFF_X1), {}};
              gemm_phase((const bf16_t*)(ws + OFF_MERGED), (const bf16_t*)(ws + OFF_WTOUT), 2048, 64, 8, e); })
  PHASE(11, { norm_mod_phase<true>((const float*)(ws + OFF_X1), nullptr, p.in[I_NORM2], mod, 3, 4, (bf16_t*)(ws + OFF_H2)); ffconv_phase(p); })
  PHASE(12, { EpiFF1 e{(bf16_t*)(ws + OFF_FF)};
              gemm_phase((const bf16_t*)(ws + OFF_H2), (const bf16_t*)(ws + OFF_WTFFIN), 2048, 64, 32, e); })
  PHASE(13, { EpiFF2 e{mod, p.out, (const bf16_t*)(ws + OFF_X1), {}};
              gemm_phase((const bf16_t*)(ws + OFF_FF), (const bf16_t*)(ws + OFF_WTFFOUT), 8192, 64, 8, e); })
}

extern "C" void kernel_launch(void* const* d_in, const int* in_sizes, int n_in, void* d_out, int out_size, void* d_ws, size_t ws_size, hipStream_t stream) {
  static int grid_blocks = 0;
  if (n_in != 32 || ws_size < WS_NEED) { fprintf(stderr, "kernel_launch: bad n_in %d or ws_size %zu (need %zu)\n", n_in, ws_size, (size_t)WS_NEED); return; }
  if (!grid_blocks) {
    int dev = 0, cus = 0, per_cu = 0;
    hipGetDevice(&dev);
    hipDeviceGetAttribute(&cus, hipDeviceAttributeMultiprocessorCount, dev);
    hipFuncSetAttribute((const void*)fwd_megakernel, hipFuncAttributeMaxDynamicSharedMemorySize, SHM_BYTES);
    hipOccupancyMaxActiveBlocksPerMultiprocessor(&per_cu, fwd_megakernel, 512, SHM_BYTES);
    if (per_cu < 1) per_cu = 1;
    grid_blocks = cus * 1;
    if (grid_blocks > 256) grid_blocks = 256;
    grid_blocks &= ~7;
  }
  Params p{};
  for (int i = 0; i < 32; ++i) p.in[i] = (const float*)d_in[i];
  p.out = (float*)d_out; p.ws = (char*)d_ws;
#ifdef PROBE_PHASES
  { const int probe[] = {PROBE_PHASES}; int cur = 0;
    auto launch = [&](int l2, int h2) { void* a2[] = {&p, &l2, &h2}; hipMemsetAsync((char*)d_ws + OFF_XBAR, 0, XCD_BAR_WORDS * 4, stream);
      hipError_t e = hipLaunchCooperativeKernel((void*)fwd_megakernel, dim3(grid_blocks), dim3(512), a2, SHM_BYTES, stream);
      if (e != hipSuccess) fprintf(stderr, "cooperative launch failed: %s (grid %d)\n", hipGetErrorString(e), grid_blocks); };
    for (unsigned i = 0; i < sizeof(probe) / sizeof(int); ++i) { launch(cur, probe[i] + 1); launch(probe[i], probe[i] + 1); cur = probe[i] + 1; }
    if (cur < 14) launch(cur, 14); }
#else
  int lo = 0, hi = 14;
  void* args[] = {&p, &lo, &hi};
  hipMemsetAsync((char*)d_ws + OFF_XBAR, 0, XCD_BAR_WORDS * 4, stream);
  hipError_t e = hipLaunchCooperativeKernel((void*)fwd_megakernel, dim3(grid_blocks), dim3(512), args, SHM_BYTES, stream);
  if (e != hipSuccess) fprintf(stderr, "cooperative launch failed: %s (grid %d)\n", hipGetErrorString(e), grid_blocks);
#endif
}
```
